# Optimizing an MI355X kernel written in HIP

```python
import jax, jax.numpy as jnp
from jax import lax
import numpy as np

D_MODEL = 2048
BATCH = 1
SEQ = 16384
DEPTH = 2

CHUNK = 64
LEFT_CHUNKS = 8
BAND = (LEFT_CHUNKS + 1) * CHUNK
MIX_WIDTH = D_MODEL
WIDTH_A = MIX_WIDTH // 2
N_HEADS_A = 8
HEAD_DIM_A = WIDTH_A // N_HEADS_A
REL_CLIP = 256
WIDTH_B = MIX_WIDTH - WIDTH_A
N_GROUPS_B = 8
GROUP_DIM_B = WIDTH_B // N_GROUPS_B
GMLP_BLOCK = 128
IN_PROJ = 3 * WIDTH_A + 2 * WIDTH_B
N_MEM = 256
N_HEADS_MEM = 4
HEAD_DIM_MEM = D_MODEL // N_HEADS_MEM
D_FF = ((8 * D_MODEL // 3 + 127) // 128) * 128
EPS = 1e-6
NEG = -1e30

kernel_name = "chunk_causal_hybrid_attn_gmlp_macaron"


def rmsnorm(x, g):
    xf = x.astype(jnp.float32)
    y = xf * lax.rsqrt(jnp.mean(xf * xf, axis=-1, keepdims=True) + EPS)
    return (y * g.astype(jnp.float32)).astype(x.dtype)


def layernorm(x, g, b):
    xf = x.astype(jnp.float32)
    mu = jnp.mean(xf, axis=-1, keepdims=True)
    xc = xf - mu
    y = xc * lax.rsqrt(jnp.mean(xc * xc, axis=-1, keepdims=True) + EPS)
    return (y * g.astype(jnp.float32) + b.astype(jnp.float32)).astype(x.dtype)


def swiglu(h, w_in, w_out):
    a, b = jnp.split(h @ w_in, 2, axis=-1)
    return (jax.nn.silu(a) * b) @ w_out


def rel_bias_band(table):
    s = jnp.arange(CHUNK)[:, None]
    j = jnp.arange(BAND)[None, :]
    dist = LEFT_CHUNKS * CHUNK + s - j
    idx = jnp.clip(dist, -REL_CLIP, REL_CLIP) + REL_CLIP
    return table[:, idx]


def chunk_attention(q, k, v, g_q, g_k, rel_table):
    b, s, h, dh = q.shape
    nc = s // CHUNK
    q = rmsnorm(q, g_q)
    k = rmsnorm(k, g_k)
    qc = q.reshape(b, nc, CHUNK, h, dh)
    pad = ((0, 0), (LEFT_CHUNKS, 0), (0, 0), (0, 0), (0, 0))
    kp = jnp.pad(k.reshape(b, nc, CHUNK, h, dh), pad)
    vp = jnp.pad(v.reshape(b, nc, CHUNK, h, dh), pad)
    band_idx = jnp.arange(nc)[:, None] + jnp.arange(LEFT_CHUNKS + 1)[None, :]
    kb = kp[:, band_idx].reshape(b, nc, BAND, h, dh)
    vb = vp[:, band_idx].reshape(b, nc, BAND, h, dh)
    scores = jnp.einsum('bcqhd,bckhd->bchqk', qc, kb).astype(jnp.float32) * (dh ** -0.5)
    scores = scores + rel_bias_band(rel_table).astype(jnp.float32)[None, None]
    valid = jnp.repeat(band_idx >= LEFT_CHUNKS, CHUNK, axis=1)
    scores = jnp.where(valid[None, :, None, None, :], scores, NEG)
    p = jax.nn.softmax(scores, axis=-1).astype(v.dtype)
    o = jnp.einsum('bchqk,bckhd->bcqhd', p, vb)
    return o.reshape(b, s, h * dh)


def gmlp_spatial_gate(u, v, ln_g, ln_b, w_s, b_s):
    b, s, _ = v.shape
    nb = s // GMLP_BLOCK
    v = layernorm(v, ln_g, ln_b)
    vb = v.reshape(b, nb, GMLP_BLOCK, N_GROUPS_B, GROUP_DIM_B)
    pos = jnp.arange(GMLP_BLOCK)
    mask = (pos[:, None] // CHUNK) >= (pos[None, :] // CHUNK)
    ws = jnp.where(mask[None], w_s, jnp.zeros_like(w_s))
    mixed = jnp.einsum('gst,bntgc->bnsgc', ws, vb) + b_s.T[None, None, :, :, None]
    return u * mixed.reshape(b, s, WIDTH_B)


def memory_attention(h, m, w_q, w_kv, w_o, g_q, g_k):
    b, s, _ = h.shape
    nm = m.shape[1]
    q = rmsnorm((h @ w_q).reshape(b, s, N_HEADS_MEM, HEAD_DIM_MEM), g_q)
    k, v = jnp.split(m @ w_kv, 2, axis=-1)
    k = rmsnorm(k.reshape(b, nm, N_HEADS_MEM, HEAD_DIM_MEM), g_k)
    v = v.reshape(b, nm, N_HEADS_MEM, HEAD_DIM_MEM)
    scores = jnp.einsum('bshd,bmhd->bhsm', q, k).astype(jnp.float32) * (HEAD_DIM_MEM ** -0.5)
    p = jax.nn.softmax(scores, axis=-1).astype(v.dtype)
    o = jnp.einsum('bhsm,bmhd->bshd', p, v)
    return o.reshape(b, s, D_MODEL) @ w_o


def setup_inputs(seed: int = 0) -> dict:
    key = jax.random.key(seed)
    ks = jax.random.split(key, 32)
    L = DEPTH

    def w(k, shape, fan_in):
        return jax.random.normal(k, shape, jnp.float32) * (fan_in ** -0.5)

    def gain(k, shape):
        return 1.0 + 0.02 * jax.random.normal(k, shape, jnp.float32)

    return {
        "x": jax.random.normal(ks[0], (BATCH, SEQ, D_MODEL), jnp.float32),
        "mem": jax.random.normal(ks[1], (BATCH, N_MEM, D_MODEL), jnp.float32),
        "g_ffn1": gain(ks[2], (L, D_MODEL)),
        "w_ffn1_in": w(ks[3], (L, D_MODEL, 2 * D_FF), D_MODEL),
        "w_ffn1_out": w(ks[4], (L, D_FF, D_MODEL), D_FF),
        "g_mix": gain(ks[5], (L, D_MODEL)),
        "w_in": w(ks[6], (L, D_MODEL, IN_PROJ), D_MODEL),
        "g_q_a": gain(ks[7], (L, HEAD_DIM_A)),
        "g_k_a": gain(ks[8], (L, HEAD_DIM_A)),
        "rel_table": 0.1 * jax.random.normal(ks[9], (L, N_HEADS_A, 2 * REL_CLIP + 1), jnp.float32),
        "ln_v_g": gain(ks[10], (L, WIDTH_B)),
        "ln_v_b": 0.02 * jax.random.normal(ks[11], (L, WIDTH_B), jnp.float32),
        "w_s": w(ks[12], (L, N_GROUPS_B, GMLP_BLOCK, GMLP_BLOCK), GMLP_BLOCK),
        "b_s": gain(ks[13], (L, N_GROUPS_B, GMLP_BLOCK)),
        "g_out_a": gain(ks[14], (L, WIDTH_A)),
        "g_out_b": gain(ks[15], (L, WIDTH_B)),
        "w_out": w(ks[16], (L, MIX_WIDTH, D_MODEL), MIX_WIDTH),
        "g_mem_q": gain(ks[17], (L, D_MODEL)),
        "g_mem_kv": gain(ks[18], (L, D_MODEL)),
        "w_mem_q": w(ks[19], (L, D_MODEL, D_MODEL), D_MODEL),
        "w_mem_kv": w(ks[20], (L, D_MODEL, 2 * D_MODEL), D_MODEL),
        "w_mem_o": w(ks[21], (L, D_MODEL, D_MODEL), D_MODEL),
        "g_q_mem": gain(ks[22], (L, HEAD_DIM_MEM)),
        "g_k_mem": gain(ks[23], (L, HEAD_DIM_MEM)),
        "g_ffn2": gain(ks[24], (L, D_MODEL)),
        "w_ffn2_in": w(ks[25], (L, D_MODEL, 2 * D_FF), D_MODEL),
        "w_ffn2_out": w(ks[26], (L, D_FF, D_MODEL), D_FF),
    }


def reference(x, mem, g_ffn1, w_ffn1_in, w_ffn1_out, g_mix, w_in, g_q_a, g_k_a, rel_table,
              ln_v_g, ln_v_b, w_s, b_s, g_out_a, g_out_b, w_out, g_mem_q, g_mem_kv,
              w_mem_q, w_mem_kv, w_mem_o, g_q_mem, g_k_mem, g_ffn2, w_ffn2_in, w_ffn2_out):
    b, s, _ = x.shape
    splits = [WIDTH_A, 2 * WIDTH_A, 3 * WIDTH_A, 3 * WIDTH_A + WIDTH_B]
    for l in range(DEPTH):
        x = x + 0.5 * swiglu(rmsnorm(x, g_ffn1[l]), w_ffn1_in[l], w_ffn1_out[l])
        h = rmsnorm(x, g_mix[l])
        z = h @ w_in[l]
        qa, ka, va, zu, zv = jnp.split(z, splits, axis=-1)
        heads = (b, s, N_HEADS_A, HEAD_DIM_A)
        y_a = chunk_attention(qa.reshape(heads), ka.reshape(heads), va.reshape(heads),
                              g_q_a[l], g_k_a[l], rel_table[l])
        y_b = gmlp_spatial_gate(jax.nn.gelu(zu), jax.nn.gelu(zv), ln_v_g[l], ln_v_b[l],
                                w_s[l], b_s[l])
        y = jnp.concatenate([rmsnorm(y_a, g_out_a[l]), rmsnorm(y_b, g_out_b[l])], axis=-1)
        x = x + y @ w_out[l]
        x = x + memory_attention(rmsnorm(x, g_mem_q[l]), rmsnorm(mem, g_mem_kv[l]),
                                 w_mem_q[l], w_mem_kv[l], w_mem_o[l], g_q_mem[l], g_k_mem[l])
        x = x + 0.5 * swiglu(rmsnorm(x, g_ffn2[l]), w_ffn2_in[l], w_ffn2_out[l])
    return x
```

```cpp
#include <hip/hip_runtime.h>
#include <hip/hip_cooperative_groups.h>
#include <cstdio>
#include <cstdint>
namespace cg = cooperative_groups;

#define LAS __attribute__((address_space(3)))
typedef unsigned short bf16_t;
typedef short bf16x8 __attribute__((ext_vector_type(8)));
typedef float f32x4 __attribute__((ext_vector_type(4)));
typedef float f32x2 __attribute__((ext_vector_type(2)));
typedef unsigned u32x4 __attribute__((ext_vector_type(4)));
typedef unsigned u32x2 __attribute__((ext_vector_type(2)));

constexpr int S_ = 16384, D_ = 2048, FF_ = 5504, NIN_ = 5120, NMEM_ = 256;
constexpr float EPS_ = 1e-6f;
constexpr int NWAVES = 8;
constexpr int LDS_BYTES = 147456;

constexpr size_t SZ_W1 = (size_t)2 * FF_ * D_ * 2, SZ_W2 = (size_t)D_ * FF_ * 2, SZ_WIN = (size_t)NIN_ * D_ * 2, SZ_DD = (size_t)D_ * D_ * 2, SZ_WKV = (size_t)2 * D_ * D_ * 2;
constexpr size_t LO_W1A = 0, LO_W2A = LO_W1A + SZ_W1, LO_WIN = LO_W2A + SZ_W2, LO_WOUT = LO_WIN + SZ_WIN, LO_WQ = LO_WOUT + SZ_DD, LO_WO = LO_WQ + SZ_DD,
                 LO_W1B = LO_WO + SZ_DD, LO_W2B = LO_W1B + SZ_W1, LO_VW = LO_W2B + SZ_W2, LO_END = LO_VW + (size_t)D_ * 1024 * 2;
constexpr size_t WS_WKV = 2 * LO_END, WS_WSM = WS_WKV + 2 * SZ_WKV, WS_AMEM = WS_WSM + (size_t)2 * 8 * 128 * 128 * 2, WS_KVALL = WS_AMEM + (size_t)512 * 2048 * 2,
                 WS_KN = WS_KVALL + (size_t)512 * 8192 * 2, WS_XN = WS_KN + (size_t)2 * 256 * 2048 * 2, WS_H = WS_XN + (size_t)S_ * D_ * 2, WS_Y = WS_H + (size_t)S_ * FF_ * 2,
                 WS_SS = WS_Y + (size_t)S_ * D_ * 2, WS_BAR = WS_SS + (size_t)S_ * 32 * 4, WS_QS = WS_BAR + 16384, WS_VS = WS_QS + (size_t)S_ * 32 * 8, WS_YS = WS_VS + (size_t)S_ * 16 * 8, WS_END = WS_YS + (size_t)S_ * 16 * 4;
constexpr size_t H_OFF_P = (size_t)80 << 20;

__device__ __forceinline__ unsigned cvt_pk_bf16(float lo, float hi) { unsigned r; asm("v_cvt_pk_bf16_f32 %0, %1, %2" : "=v"(r) : "v"(lo), "v"(hi)); return r; }
__device__ __forceinline__ float bf_lo(unsigned u) { return __uint_as_float(u << 16); }
__device__ __forceinline__ float bf_hi(unsigned u) { return __uint_as_float(u & 0xffff0000u); }
__device__ __forceinline__ float fast_exp(float x) { return __builtin_amdgcn_exp2f(x * 1.44269504089f); }
__device__ __forceinline__ float silu_f(float a) { return a * __builtin_amdgcn_rcpf(1.0f + fast_exp(-a)); }
__device__ __forceinline__ float gelu_f(float x) { const float y = 1.5957691216f * (x + 0.044715f * x * x * x); return x * __builtin_amdgcn_rcpf(1.0f + fast_exp(-y)); }
__device__ __forceinline__ float shx(float v, int m) {
    int l_ = (int)__builtin_amdgcn_mbcnt_hi(~0u, __builtin_amdgcn_mbcnt_lo(~0u, 0u)); asm volatile("" : "+v"(l_)); const int idx = (l_ ^ m) << 2;
    return __builtin_bit_cast(float, __builtin_amdgcn_ds_bpermute(idx, __builtin_bit_cast(int, v)));
}
__device__ __forceinline__ float wave_sum(float v) {
#pragma unroll
    for (int o = 1; o < 64; o <<= 1) v += shx(v, o);
    return v;
}

namespace pg8 {
constexpr int BM = 256, BK = 64, HALF = 128, HTB = HALF * BK * 2, STAGE_BYTES = 8 * HTB, NXCD = 8, WGM = 8;
__host__ __device__ __forceinline__ int lds_byte(int r, int c) { const int st = (r >> 4) * 2 + (c >> 5), rr = r & 15, cc = c & 31, ob = rr * 64 + cc * 2; return st * 1024 + (ob ^ (((ob >> 9) & 1) << 5)); }
__host__ __device__ __forceinline__ void stage_rc(int b, int& R, int& C) { const int st = b / 1024, sb = b % 1024, swz = sb ^ (((sb >> 9) & 1) << 5); R = (st >> 1) * 16 + swz / 64; C = (st & 1) * 32 + (swz % 64) / 2; }
__host__ __device__ __forceinline__ int perm32(int rho) { const int n = rho >> 4, i = rho & 15; return 8 * (i >> 2) + 4 * n + (i & 3); }

struct Unit { int pm, pn; };
struct Gemm { const bf16_t* A; const bf16_t* Bt; int lda, ldb, K, nM, nN; unsigned a_pm, a_pn, b_pm, b_pn; int bx_off; };

struct StaticOrder {
    int nM, nN, nwg, G, c;
    __device__ void init(int nM_, int nN_, int G_, int c_) { nM = nM_; nN = nN_; nwg = nM * nN; G = G_; c = c_; }
    __device__ bool next(int i, Unit& u) const {
        const int L = i * G + c; if (L >= nwg) return false;
        int wgid = L; { const int q = nwg / NXCD, r = nwg % NXCD, xcd = wgid % NXCD, off = wgid / NXCD; wgid = (xcd < r ? xcd * (q + 1) : r * (q + 1) + (xcd - r) * q) + off; }
        const int nig = WGM * nN, gid = wgid / nig, fm = gid * WGM, gsz = (nM - fm) < WGM ? (nM - fm) : WGM;
        u.pm = fm + ((wgid % nig) % gsz); u.pn = (wgid % nig) / gsz; return true;
    }
};

template <int MODE, bool FLAG = false, bool STATS = false> struct Epi {
    static constexpr bool MIDK = (MODE == 5);
    void* out; int ldc; const float* base; float scale; int gelu_pn; const float* ss; bf16_t* xb; float* sso; float* st; int st_n, st_pn0; LAS unsigned char* xch;
    __device__ __forceinline__ void row_vars(const Unit& u, int ai, int wr, int fr, int fq, float (&va)[4], float (&vb)[4]) const {
        const int row0 = u.pm * BM + wr * 64 + fr + ai * HALF; f32x4 q[4];
#pragma unroll
        for (int m = 0; m < 4; ++m) q[m] = *(const f32x4*)(ss + (size_t)(row0 + m * 16) * 16 + 4 * fq);
#pragma unroll
        for (int m = 0; m < 4; ++m) { float t = (q[m][0] + q[m][1]) + (q[m][2] + q[m][3]); t += shx(t, 16); const float o = shx(t, 32);
            va[m] = (fq < 2 ? t : o) * (1.0f / 1024.0f) + EPS_; vb[m] = (fq < 2 ? o : t) * (1.0f / 1024.0f) + EPS_; }
    }
    __device__ __forceinline__ void midk_factors(float (&fm)[2][4], const Unit& u, int wr, int fr, int fq) const {
#pragma unroll
        for (int ai = 0; ai < 2; ++ai) {
            float va[4], vb[4]; row_vars(u, ai, wr, fr, fq, va, vb);
#pragma unroll
            for (int m = 0; m < 4; ++m) fm[ai][m] = sqrtf(vb[m] / va[m]);
        }
    }
    __device__ __forceinline__ void operator()(const f32x4 (&acc)[2][2][4][2], const Unit& u, int wr, int wc, int fr, int fq) const {
        const int row0 = u.pm * BM + wr * 64 + fr;
        float rs[2][4];
        if constexpr (MODE == 0 || MODE == 1) {
#pragma unroll
            for (int ai = 0; ai < 2; ++ai)
#pragma unroll
                for (int m = 0; m < 4; ++m) rs[ai][m] = 1.0f;
            if constexpr (FLAG) {
                f32x4 x0[2][4], x1[2][4];
#pragma unroll
                for (int ai = 0; ai < 2; ++ai)
#pragma unroll
                    for (int m = 0; m < 4; ++m) { const float* p = ss + (size_t)(row0 + ai * HALF + m * 16) * 32 + fq * 8; x0[ai][m] = *(const f32x4*)p; x1[ai][m] = *(const f32x4*)(p + 4); }
#pragma unroll
                for (int ai = 0; ai < 2; ++ai)
#pragma unroll
                    for (int m = 0; m < 4; ++m) {
                        float t = ((x0[ai][m][0] + x0[ai][m][1]) + (x0[ai][m][2] + x0[ai][m][3])) + ((x1[ai][m][0] + x1[ai][m][1]) + (x1[ai][m][2] + x1[ai][m][3])); t += shx(t, 16); t += shx(t, 32);
                        rs[ai][m] = 1.0f / sqrtf(t * (1.0f / 2048.0f) + EPS_); }
            }
        }
        if constexpr (MODE == 1) {
            bf16_t* O = (bf16_t*)out; const int col0 = u.pn * HALF + wc * 32 + 8 * fq;
#pragma unroll
            for (int ai = 0; ai < 2; ++ai)
#pragma unroll
                for (int m = 0; m < 4; ++m) {
                    const float r = rs[ai][m];
                    const f32x4 a0 = acc[ai][0][m][0] * r, a1 = acc[ai][0][m][1] * r, b0 = acc[ai][1][m][0] * r, b1 = acc[ai][1][m][1] * r;
                    u32x4 w;
                    w.x = cvt_pk_bf16(silu_f(a0[0]) * b0[0], silu_f(a0[1]) * b0[1]); w.y = cvt_pk_bf16(silu_f(a0[2]) * b0[2], silu_f(a0[3]) * b0[3]);
                    w.z = cvt_pk_bf16(silu_f(a1[0]) * b1[0], silu_f(a1[1]) * b1[1]); w.w = cvt_pk_bf16(silu_f(a1[2]) * b1[2], silu_f(a1[3]) * b1[3]);
                    *(u32x4*)(O + (size_t)(row0 + ai * HALF + m * 16) * ldc + col0) = w;
                }
        } else if constexpr (MODE == 2 || MODE == 5) {
            constexpr bool XBF = FLAG || MODE == 5;
            const int col0 = u.pn * BM + wc * 32 + 8 * fq;
#pragma unroll
            for (int ai = 0; ai < 2; ++ai) {
                float rb5[4] = {1.f, 1.f, 1.f, 1.f};
                if constexpr (MODE == 5) { float va[4], vb[4]; row_vars(u, ai, wr, fr, fq, va, vb);
#pragma unroll
                    for (int m = 0; m < 4; ++m) rb5[m] = 1.0f / sqrtf(vb[m]); }
                f32x4 bs[4][2][2];
#pragma unroll
                for (int m = 0; m < 4; ++m)
#pragma unroll
                    for (int bj = 0; bj < 2; ++bj) { const float* bp = base + (size_t)(row0 + ai * HALF + m * 16) * ldc + col0 + bj * HALF; bs[m][bj][0] = *(const f32x4*)bp; bs[m][bj][1] = *(const f32x4*)(bp + 4); }
#pragma unroll
                for (int m = 0; m < 4; ++m) {
                    const size_t roff = (size_t)(row0 + ai * HALF + m * 16) * ldc + col0;
                    float sq = 0.f;
#pragma unroll
                    for (int bj = 0; bj < 2; ++bj) {
                        const float sc = (MODE == 5) ? rb5[m] : scale;
                        const f32x4 x0 = bs[m][bj][0] + acc[ai][bj][m][0] * sc, x1 = bs[m][bj][1] + acc[ai][bj][m][1] * sc;
                        *(f32x4*)((float*)out + roff + bj * HALF) = x0; *(f32x4*)((float*)out + roff + bj * HALF + 4) = x1;
                        if constexpr (XBF) {
                            u32x4 w; w.x = cvt_pk_bf16(x0[0], x0[1]); w.y = cvt_pk_bf16(x0[2], x0[3]); w.z = cvt_pk_bf16(x1[0], x1[1]); w.w = cvt_pk_bf16(x1[2], x1[3]);
                            *(u32x4*)(xb + roff + bj * HALF) = w;
                            sq += ((x0[0] * x0[0] + x0[1] * x0[1]) + (x0[2] * x0[2] + x0[3] * x0[3])) + ((x1[0] * x1[0] + x1[1] * x1[1]) + (x1[2] * x1[2] + x1[3] * x1[3]));
                        }
                    }
                    if constexpr (XBF) { sq += shx(sq, 16); sq += shx(sq, 32); sso[(size_t)(row0 + ai * HALF + m * 16) * 32 + u.pn * 4 + wc] = sq; }
                }
            }
        } else if constexpr (MODE == 4) {
            float rq[2][4], mw[2][4], sw[2][4];
            {   f32x4 q4[2][4];
#pragma unroll
                for (int ai = 0; ai < 2; ++ai)
#pragma unroll
                    for (int m = 0; m < 4; ++m) q4[ai][m] = *(const f32x4*)(ss + ((size_t)(row0 + ai * HALF + m * 16) * 32 + 8 * u.pn + 2 * fq) * 2);
#pragma unroll
                for (int ai = 0; ai < 2; ++ai)
#pragma unroll
                    for (int m = 0; m < 4; ++m) { float t = q4[ai][m][1] + q4[ai][m][3]; t += shx(t, 16); t += shx(t, 32); rq[ai][m] = 1.0f / sqrtf(t * (1.0f / 512.0f) + EPS_); } }
            typedef float f32x2v __attribute__((ext_vector_type(2)));
            LAS f32x2v* X2 = (LAS f32x2v*)xch;
#pragma unroll
            for (int ai = 0; ai < 2; ++ai)
#pragma unroll
                for (int m = 0; m < 4; ++m) {
                    const float r = rq[ai][m]; float mx = -1e30f;
#pragma unroll
                    for (int bj = 0; bj < 2; ++bj)
#pragma unroll
                        for (int n = 0; n < 2; ++n)
#pragma unroll
                            for (int e = 0; e < 4; ++e) mx = fmaxf(mx, acc[ai][bj][m][n][e] * r);
                    mx = fmaxf(mx, shx(mx, 16)); mx = fmaxf(mx, shx(mx, 32));
                    float sm = 0.f;
#pragma unroll
                    for (int bj = 0; bj < 2; ++bj)
#pragma unroll
                        for (int n = 0; n < 2; ++n)
#pragma unroll
                            for (int e = 0; e < 4; ++e) sm += fast_exp(acc[ai][bj][m][n][e] * r - mx);
                    sm += shx(sm, 16); sm += shx(sm, 32);
                    mw[ai][m] = mx; sw[ai][m] = sm;
                    X2[(ai * HALF + wr * 64 + m * 16 + fr) * 4 + wc] = (f32x2v){mx, sm};
                }
            asm volatile("s_waitcnt lgkmcnt(0)" ::: "memory"); __builtin_amdgcn_s_barrier(); asm volatile("" ::: "memory");
            bf16_t* O = (bf16_t*)out; const int col0 = u.pn * BM + wc * 32 + 8 * fq;
#pragma unroll
            for (int ai = 0; ai < 2; ++ai)
#pragma unroll
                for (int m = 0; m < 4; ++m) {
                    const LAS f32x4* xp = (const LAS f32x4*)(X2 + (ai * HALF + wr * 64 + m * 16 + fr) * 4);
                    const f32x4 p0 = xp[0], p1 = xp[1];
                    const float M = fmaxf(fmaxf(p0[0], p0[2]), fmaxf(p1[0], p1[2]));
                    const float tot = (p0[1] * fast_exp(p0[0] - M) + p0[3] * fast_exp(p0[2] - M)) + (p1[1] * fast_exp(p1[0] - M) + p1[3] * fast_exp(p1[2] - M));
                    const float r = rq[ai][m], mo = mw[ai][m], f = fast_exp(mo - M) / tot;
#pragma unroll
                    for (int bj = 0; bj < 2; ++bj) {
                        const f32x4 v0 = acc[ai][bj][m][0], v1 = acc[ai][bj][m][1]; u32x4 w;
                        w.x = cvt_pk_bf16(fast_exp(v0[0] * r - mo) * f, fast_exp(v0[1] * r - mo) * f); w.y = cvt_pk_bf16(fast_exp(v0[2] * r - mo) * f, fast_exp(v0[3] * r - mo) * f);
                        w.z = cvt_pk_bf16(fast_exp(v1[0] * r - mo) * f, fast_exp(v1[1] * r - mo) * f); w.w = cvt_pk_bf16(fast_exp(v1[2] * r - mo) * f, fast_exp(v1[3] * r - mo) * f);
                        *(u32x4*)(O + (size_t)(row0 + ai * HALF + m * 16) * ldc + col0 + bj * HALF) = w;
                    }
                }
            (void)sw;
        } else {
            const int col0 = u.pn * BM + wc * 32 + 8 * fq;
            const bool do_gelu = (MODE == 0) && (u.pn >= gelu_pn);
#pragma unroll
            for (int ai = 0; ai < 2; ++ai)
#pragma unroll
                for (int m = 0; m < 4; ++m) {
                    const size_t roff = (size_t)(row0 + ai * HALF + m * 16) * ldc + col0;
                    float s1 = 0.f, s2 = 0.f;
#pragma unroll
                    for (int bj = 0; bj < 2; ++bj) {
                        f32x4 v0 = acc[ai][bj][m][0], v1 = acc[ai][bj][m][1];
                        if constexpr (MODE == 0) {
                            v0 = v0 * rs[ai][m]; v1 = v1 * rs[ai][m];
                            if (do_gelu) {
#pragma unroll
                                for (int e = 0; e < 4; ++e) { v0[e] = gelu_f(v0[e]); v1[e] = gelu_f(v1[e]); }
                            }
                            if constexpr (STATS) {
                                s1 += ((v0[0] + v0[1]) + (v0[2] + v0[3])) + ((v1[0] + v1[1]) + (v1[2] + v1[3]));
                                s2 += ((v0[0] * v0[0] + v0[1] * v0[1]) + (v0[2] * v0[2] + v0[3] * v0[3])) + ((v1[0] * v1[0] + v1[1] * v1[1]) + (v1[2] * v1[2] + v1[3] * v1[3]));
                            }
                            u32x4 w; w.x = cvt_pk_bf16(v0[0], v0[1]); w.y = cvt_pk_bf16(v0[2], v0[3]); w.z = cvt_pk_bf16(v1[0], v1[1]); w.w = cvt_pk_bf16(v1[2], v1[3]);
                            *(u32x4*)((bf16_t*)out + roff + bj * HALF) = w;
                        } else {
                            *(f32x4*)((float*)out + roff + bj * HALF) = v0 * scale; *(f32x4*)((float*)out + roff + bj * HALF + 4) = v1 * scale;
                        }
                    }
                    if constexpr (MODE == 0 && STATS) {
                        s1 += shx(s1, 16); s1 += shx(s1, 32); s2 += shx(s2, 16); s2 += shx(s2, 32);
                        if (u.pn >= st_pn0) *(f32x2*)(st + ((size_t)(row0 + ai * HALF + m * 16) * st_n + 4 * (u.pn - st_pn0) + wc) * 2) = (f32x2){s1, s2};
                    }
                }
        }
    }
};

template <class EpiT>
__device__ __forceinline__ void gemm_phase(LAS unsigned char* lds, const Gemm g, const EpiT& E) {
    int tid = threadIdx.x; asm volatile("" : "+v"(tid));
    const int wid = __builtin_amdgcn_readfirstlane(tid >> 6), lane = tid & 63, wr = wid >> 2, wc = wid & 3, fr = lane & 15, fq = lane >> 4;
    constexpr int KS = EpiT::MIDK ? 2 : 1;
    const int K = g.K, nt = K / BK / KS;
    const unsigned segstep = (unsigned)(nt * BK * 2);
    int bx_ = (int)((blockIdx.x + (unsigned)g.bx_off) % gridDim.x); asm volatile("" : "+s"(bx_));
    StaticOrder S; S.init(g.nM, g.nN, (int)gridDim.x, bx_);
    unsigned voffA[2], voffB[2];
#pragma unroll
    for (int i = 0; i < 2; ++i) { int R, C; stage_rc(tid * 16 + i * 8192, R, C); const int Rb = (R & ~31) + perm32(R & 31);
        voffA[i] = (unsigned)(R * g.lda + C) * 2u; voffB[i] = (unsigned)(Rb * g.ldb + C) * 2u; }
    const size_t kstep = (size_t)(BK * 2);
    const unsigned hstepA = (unsigned)HALF * g.lda * 2u, hstepB = (unsigned)HALF * g.ldb * 2u;
    const unsigned ldsw = (unsigned)wid * 1024u;
    const int aoff = lds_byte(wr * 64 + fr, fq * 8), boff = lds_byte(wc * 32 + fr, fq * 8);
#define PG8_SA(b, h) (((b) * 2 + (h)) * HTB)
#define PG8_SB(b, h) ((4 + (b) * 2 + (h)) * HTB)
#define PG8_STAGE(bufoff, gbase, voff) do { _Pragma("unroll") for (int _i = 0; _i < 2; ++_i) \
        __builtin_amdgcn_global_load_lds((const unsigned*)((const char*)(gbase) + (voff)[_i]), (LAS unsigned*)(lds + (bufoff) + ldsw + _i * 8192), 16, 0, 0); } while (0)
#define PG8_LDA(dst, b, h) do { _Pragma("unroll") for (int m = 0; m < 4; ++m) _Pragma("unroll") for (int k = 0; k < 2; ++k) dst[m][k] = *(const LAS bf16x8*)(lds + PG8_SA(b, h) + aoff + m * 2048 + k * 1024); } while (0)
#define PG8_LDB(dst, b, h) do { _Pragma("unroll") for (int n = 0; n < 2; ++n) _Pragma("unroll") for (int k = 0; k < 2; ++k) dst[n][k] = *(const LAS bf16x8*)(lds + PG8_SB(b, h) + boff + n * 2048 + k * 1024); } while (0)
#define PG8_MMA(ai, bj, At, Bt) do { __builtin_amdgcn_s_setprio(1); _Pragma("unroll") for (int m = 0; m < 4; ++m) _Pragma("unroll") for (int n = 0; n < 2; ++n) _Pragma("unroll") for (int k = 0; k < 2; ++k) \
        acc[ai][bj][m][n] = __builtin_amdgcn_mfma_f32_16x16x32_bf16(Bt[n][k], At[m][k], acc[ai][bj][m][n], 0, 0, 0); __builtin_amdgcn_s_setprio(0); } while (0)
#define PG8_WAIT_V(n) asm volatile("s_waitcnt vmcnt(" #n ")" ::: "memory")
#define PG8_WAIT_L(n) asm volatile("s_waitcnt lgkmcnt(" #n ")" ::: "memory")
#define PG8_BAR __builtin_amdgcn_s_barrier()
#define PG8_SCHED __builtin_amdgcn_sched_barrier(0)
    Unit cur, nxt; int ui = 0;
    if (!S.next(0, cur)) return;
    f32x4 acc[2][2][4][2];
#pragma unroll
    for (int a = 0; a < 2; ++a)
#pragma unroll
        for (int b = 0; b < 2; ++b)
#pragma unroll
            for (int m = 0; m < 4; ++m)
#pragma unroll
                for (int n = 0; n < 2; ++n) acc[a][b][m][n] = (f32x4){0.f, 0.f, 0.f, 0.f};
    bf16x8 At[4][2], B0[2][2], B1[2][2];
    const char* cA = (const char*)g.A + (size_t)((unsigned)cur.pm * g.a_pm + (unsigned)cur.pn * g.a_pn); const char* cB = (const char*)g.Bt + (size_t)((unsigned)cur.pm * g.b_pm + (unsigned)cur.pn * g.b_pn);
    PG8_STAGE(PG8_SB(0, 0), cB, voffB); PG8_STAGE(PG8_SB(0, 1), cB + hstepB, voffB); PG8_STAGE(PG8_SA(0, 0), cA, voffA); PG8_STAGE(PG8_SA(0, 1), cA + hstepA, voffA);
    if (wr == 1) PG8_BAR;
    PG8_WAIT_V(2); PG8_BAR;
    PG8_STAGE(PG8_SB(1, 0), cB + kstep, voffB); PG8_STAGE(PG8_SA(1, 0), cA + kstep, voffA); PG8_STAGE(PG8_SB(1, 1), cB + hstepB + kstep, voffB);
    PG8_WAIT_V(6); PG8_BAR;
    for (;;) {
        const bool seg0 = (KS == 2) && ((ui & 1) == 0);
        bool has_next; const char* nA; const char* nB;
        if (seg0) { has_next = true; nxt = cur; nA = cA + segstep; nB = cB + segstep; }
        else {
            has_next = S.next((ui + 1) / KS, nxt);
            nA = has_next ? (const char*)g.A + (size_t)((unsigned)nxt.pm * g.a_pm + (unsigned)nxt.pn * g.a_pn) : cA;
            nB = has_next ? (const char*)g.Bt + (size_t)((unsigned)nxt.pm * g.b_pm + (unsigned)nxt.pn * g.b_pn) : cB;
        }
        for (int t = 0; t < nt; t += 2) {
            const bool last = (t == nt - 2);
            const char* a1 = cA + (size_t)(t + 1) * kstep;
            const char* a2 = last ? nA : cA + (size_t)(t + 2) * kstep; const char* b2 = last ? nB : cB + (size_t)(t + 2) * kstep;
            const char* a3 = a2 + kstep; const char* b3 = b2 + kstep;
            PG8_LDB(B0, 0, 0); PG8_LDB(B1, 0, 1); PG8_SCHED; PG8_LDA(At, 0, 0); PG8_STAGE(PG8_SA(1, 1), a1 + hstepA, voffA);
            PG8_WAIT_V(8); PG8_WAIT_L(0); PG8_BAR; PG8_MMA(0, 0, At, B0); PG8_MMA(0, 1, At, B1); PG8_BAR; PG8_SCHED;
            PG8_LDA(At, 0, 1); PG8_STAGE(PG8_SB(0, 0), b2, voffB); PG8_STAGE(PG8_SB(0, 1), b2 + hstepB, voffB); PG8_STAGE(PG8_SA(0, 0), a2, voffA);
            PG8_WAIT_V(8); PG8_WAIT_L(0); PG8_BAR; PG8_MMA(1, 0, At, B0); PG8_MMA(1, 1, At, B1); PG8_BAR; PG8_SCHED;
            PG8_LDB(B0, 1, 0); PG8_LDB(B1, 1, 1); PG8_SCHED; PG8_LDA(At, 1, 0); PG8_STAGE(PG8_SA(0, 1), a2 + hstepA, voffA);
            PG8_WAIT_V(8); PG8_WAIT_L(0); PG8_BAR; PG8_MMA(0, 0, At, B0); PG8_MMA(0, 1, At, B1); PG8_BAR; PG8_SCHED;
            PG8_LDA(At, 1, 1); PG8_STAGE(PG8_SB(1, 0), b3, voffB); PG8_STAGE(PG8_SB(1, 1), b3 + hstepB, voffB); PG8_STAGE(PG8_SA(1, 0), a3, voffA);
            PG8_WAIT_V(8); PG8_WAIT_L(0); PG8_BAR; PG8_MMA(1, 0, At, B0); PG8_MMA(1, 1, At, B1); PG8_BAR; PG8_SCHED;
        }
        const int l2_ = (int)__builtin_amdgcn_mbcnt_hi(~0u, __builtin_amdgcn_mbcnt_lo(~0u, 0u)), fr2 = l2_ & 15, fq2 = l2_ >> 4;
        Unit cu2 = cur; asm volatile("" : "+s"(cu2.pm), "+s"(cu2.pn));
        if (!seg0) {
            if (wr == 0) PG8_BAR;
            E(acc, cu2, wr, wc, fr2, fq2);
            if (!has_next) break;
        }
        if constexpr (EpiT::MIDK) {
            float fm[2][4];
#pragma unroll
            for (int ai = 0; ai < 2; ++ai)
#pragma unroll
                for (int m = 0; m < 4; ++m) fm[ai][m] = 0.f;
            if (seg0) E.midk_factors(fm, cu2, wr, fr2, fq2);
#pragma unroll
            for (int ai = 0; ai < 2; ++ai)
#pragma unroll
                for (int bj = 0; bj < 2; ++bj)
#pragma unroll
                    for (int m = 0; m < 4; ++m)
#pragma unroll
                        for (int n = 0; n < 2; ++n) acc[ai][bj][m][n] = acc[ai][bj][m][n] * fm[ai][m];
        } else {
#pragma unroll
            for (int a = 0; a < 2; ++a)
#pragma unroll
                for (int b = 0; b < 2; ++b)
#pragma unroll
                    for (int m = 0; m < 4; ++m)
#pragma unroll
                        for (int n = 0; n < 2; ++n) acc[a][b][m][n] = (f32x4){0.f, 0.f, 0.f, 0.f};
        }
        cur = nxt; cA = nA; cB = nB; ++ui;
        if (!seg0) { if (wr == 1) PG8_BAR; }
    }
    PG8_WAIT_V(0);
    PG8_BAR;
#undef PG8_SA
#undef PG8_SB
#undef PG8_STAGE
#undef PG8_LDA
#undef PG8_LDB
#undef PG8_MMA
#undef PG8_WAIT_V
#undef PG8_WAIT_L
#undef PG8_BAR
#undef PG8_SCHED
}
}

#define XB_TMO      128
#define XB_XCNT(j)  (256  + 64 * (j))
#define XB_XSUB(j)  (1280 + 64 * (j))
#define XB_XGEN(j)  (2304 + 64 * (j))
#define XB_TOP      3328
#define XB_TOPGEN   3392
#define XCD_BAR_WORDS 3456
#define XB_SPIN_CAP (1u << 20)
__device__ __forceinline__ unsigned xb_ld(unsigned* p)              { return __hip_atomic_load(p, __ATOMIC_RELAXED, __HIP_MEMORY_SCOPE_AGENT); }
__device__ __forceinline__ unsigned xb_add(unsigned* p, unsigned v) { return __hip_atomic_fetch_add(p, v, __ATOMIC_RELAXED, __HIP_MEMORY_SCOPE_AGENT); }
__device__ __forceinline__ unsigned xb_xcc_id() { return (unsigned)__builtin_amdgcn_s_getreg((3 << 11) | 20) & 0xFu; }
#define XB_SPIN(cond, bar) do { unsigned _sp = 0; while (cond) { __builtin_amdgcn_s_sleep(1); \
    if ((++_sp & 255u) == 0u) { if (xb_ld(&(bar)[XB_TMO])) break; if (_sp > XB_SPIN_CAP) { atomicAdd(&(bar)[XB_TMO], 1u); break; } } } } while (0)
struct XcdBarrier { unsigned* bar; unsigned x; volatile LAS unsigned* st; };
__device__ __forceinline__ XcdBarrier xcd_barrier_post(unsigned* bar, volatile LAS unsigned* st) {
    XcdBarrier b; b.bar = bar; b.x = (unsigned)__builtin_amdgcn_readfirstlane((int)xb_xcc_id()); b.st = st;
    if (threadIdx.x == 0) (void)xb_add(&bar[XB_XCNT(b.x)], 1u);
    return b;
}
__device__ __forceinline__ void xcd_barrier_complete(unsigned* bar, unsigned x, unsigned& nloc, unsigned& nx) {
    const unsigned G = gridDim.x * gridDim.y * gridDim.z;
    unsigned sum, cnt, mine, sp = 0u;
    for (;;) {
        sum = 0u; cnt = 0u;
#pragma unroll 1
        for (unsigned j = 0; j < 16; ++j) { const unsigned c = xb_ld(&bar[XB_XCNT(j)]); sum += c; cnt += (c > 0u) ? 1u : 0u; }
        mine = xb_ld(&bar[XB_XCNT(x)]);
        if (sum == G) break;
        __builtin_amdgcn_s_sleep(1);
        if ((++sp & 255u) == 0u) { if (xb_ld(&bar[XB_TMO])) break; if (sp > XB_SPIN_CAP) { atomicAdd(&bar[XB_TMO], 1u); break; } }
    }
    nloc = mine > 0u ? mine : 1u; nx = cnt > 0u ? cnt : 1u;
}
__device__ __forceinline__ void xcd_barrier(const XcdBarrier& b) {
    asm volatile("s_waitcnt vmcnt(0)" ::: "memory");
    __syncthreads();
    if (threadIdx.x == 0) {
        unsigned* bar = b.bar; unsigned bx = b.x; asm volatile("" : "+s"(bx));
        __builtin_amdgcn_s_waitcnt(0);
        unsigned nloc = b.st[0], nx = b.st[1];
        if (nloc == 0u) { xcd_barrier_complete(bar, bx, nloc, nx); b.st[0] = nloc; b.st[1] = nx; }
        const unsigned old = xb_add(&bar[XB_XSUB(bx)], 1u);
        const unsigned gen = old / nloc;
        if (old + 1u == (gen + 1u) * nloc) {
            __builtin_amdgcn_fence(__ATOMIC_RELEASE, "agent");
            asm volatile("s_waitcnt vmcnt(0)" ::: "memory");
            const unsigned og = xb_add(&bar[XB_TOP], 1u);
            const unsigned tg = og / nx;
            if (og + 1u == (tg + 1u) * nx) xb_add(&bar[XB_TOPGEN], 1u);
            else XB_SPIN(xb_ld(&bar[XB_TOPGEN]) == tg, bar);
            __builtin_amdgcn_fence(__ATOMIC_ACQUIRE, "agent");
            xb_add(&bar[XB_XGEN(bx)], 1u);
            asm volatile("s_waitcnt vmcnt(0)" ::: "memory");
        } else {
            XB_SPIN(xb_ld(&bar[XB_XGEN(bx)]) == gen, bar);
            __builtin_amdgcn_fence(__ATOMIC_ACQUIRE, "agent");
            asm volatile("s_waitcnt vmcnt(0)" ::: "memory");
        }
    }
    __syncthreads();
}

struct Args { const float* in[27]; float* out; unsigned char* ws; };
enum { I_X = 0, I_MEM, I_G_FFN1, I_W_FFN1_IN, I_W_FFN1_OUT, I_G_MIX, I_W_IN, I_G_Q_A, I_G_K_A, I_REL, I_LN_G, I_LN_B, I_W_S, I_B_S, I_G_OUT_A, I_G_OUT_B, I_W_OUT,
       I_G_MEM_Q, I_G_MEM_KV, I_W_MEM_Q, I_W_MEM_KV, I_W_MEM_O, I_G_Q_MEM, I_G_K_MEM, I_G_FFN2, I_W_FFN2_IN, I_W_FFN2_OUT };

__device__ __forceinline__ void rms_rows_2048(const float* x, const float* g, bf16_t* o, int nrows, int gw, int NGW, int lane) {
    for (int r = gw; r < nrows; r += NGW) {
        const f32x4* xr = (const f32x4*)(x + (size_t)r * 2048) + lane;
        f32x4 v[8]; float s = 0.f;
#pragma unroll
        for (int j = 0; j < 8; ++j) { v[j] = xr[64 * j]; s += (v[j][0] * v[j][0] + v[j][1] * v[j][1]) + (v[j][2] * v[j][2] + v[j][3] * v[j][3]); }
        const float rstd = 1.0f / sqrtf(wave_sum(s) * (1.0f / 2048.0f) + EPS_);
        u32x2* op = (u32x2*)(o + (size_t)r * 2048) + lane;
#pragma unroll
        for (int j = 0; j < 8; ++j) { const f32x4 gv = ((const f32x4*)g)[lane + 64 * j]; u32x2 w; w.x = cvt_pk_bf16(v[j][0] * rstd * gv[0], v[j][1] * rstd * gv[1]); w.y = cvt_pk_bf16(v[j][2] * rstd * gv[2], v[j][3] * rstd * gv[3]); op[64 * j] = w; }
    }
}
__device__ __forceinline__ void rows_bf16_ss(const float* x, bf16_t* o, float* ss, int nrows, int gw, int NGW, int lane) {
    for (int r = gw; r < nrows; r += 2 * NGW) {
        const f32x4* xr0 = (const f32x4*)(x + (size_t)r * 2048) + lane; const f32x4* xr1 = (const f32x4*)(x + (size_t)(r + NGW) * 2048) + lane;
        u32x2* op0 = (u32x2*)(o + (size_t)r * 2048) + lane; u32x2* op1 = (u32x2*)(o + (size_t)(r + NGW) * 2048) + lane; float s0 = 0.f, s1 = 0.f;
        f32x4 v0[8], v1[8];
#pragma unroll
        for (int j = 0; j < 8; ++j) { v0[j] = xr0[64 * j]; v1[j] = xr1[64 * j]; }
#pragma unroll
        for (int j = 0; j < 8; ++j) { const f32x4 a = v0[j], b = v1[j]; s0 += (a[0] * a[0] + a[1] * a[1]) + (a[2] * a[2] + a[3] * a[3]); s1 += (b[0] * b[0] + b[1] * b[1]) + (b[2] * b[2] + b[3] * b[3]);
            u32x2 w; w.x = cvt_pk_bf16(a[0], a[1]); w.y = cvt_pk_bf16(a[2], a[3]); op0[64 * j] = w; w.x = cvt_pk_bf16(b[0], b[1]); w.y = cvt_pk_bf16(b[2], b[3]); op1[64 * j] = w; }
        s0 = wave_sum(s0); s1 = wave_sum(s1);
        if (lane < 32) { ss[(size_t)r * 32 + lane] = (lane == 0) ? s0 : 0.f; ss[(size_t)(r + NGW) * 32 + lane] = (lane == 0) ? s1 : 0.f; }
    }
}
__device__ __forceinline__ void headnorm512_rows(const bf16_t* src, int lds_, bf16_t* dst, int ldd, const float* g, const float* g2, float scale, int nrows, int gw, int NGW, int lane) {
    const int h = lane >> 4, li = lane & 15;
    for (int r = gw; r < nrows; r += NGW) {
        const u32x4* sp = (const u32x4*)(src + (size_t)r * lds_ + h * 512) + li;
        u32x4 v[4]; float s = 0.f;
#pragma unroll
        for (int i = 0; i < 4; ++i) { v[i] = sp[16 * i];
#pragma unroll
            for (int e = 0; e < 4; ++e) { const float a = bf_lo(v[i][e]), b = bf_hi(v[i][e]); s += a * a + b * b; } }
        s += shx(s, 1); s += shx(s, 2); s += shx(s, 4); s += shx(s, 8);
        const float rstd = scale / sqrtf(s * (1.0f / 512.0f) + EPS_);
        u32x4* dp = (u32x4*)(dst + (size_t)r * ldd + h * 512) + li;
#pragma unroll
        for (int i = 0; i < 4; ++i) { f32x4 g0 = *(const f32x4*)(g + (li + 16 * i) * 8), g1 = *(const f32x4*)(g + (li + 16 * i) * 8 + 4); u32x4 w;
            if (g2) { g0 = g0 * *(const f32x4*)(g2 + (li + 16 * i) * 8); g1 = g1 * *(const f32x4*)(g2 + (li + 16 * i) * 8 + 4); }
            w.x = cvt_pk_bf16(bf_lo(v[i].x) * rstd * g0[0], bf_hi(v[i].x) * rstd * g0[1]); w.y = cvt_pk_bf16(bf_lo(v[i].y) * rstd * g0[2], bf_hi(v[i].y) * rstd * g0[3]);
            w.z = cvt_pk_bf16(bf_lo(v[i].z) * rstd * g1[0], bf_hi(v[i].z) * rstd * g1[1]); w.w = cvt_pk_bf16(bf_lo(v[i].w) * rstd * g1[2], bf_hi(v[i].w) * rstd * g1[3]);
            dp[16 * i] = w; }
    }
}
__device__ __forceinline__ void zpost_rows(bf16_t* Z, const float* gq, const float* gk, const float* lng, const float* lnb, int gw, int NGW, int lane) {
    const int li = lane & 15;
    for (int r = gw; r < S_; r += NGW) {
        bf16_t* zr = Z + (size_t)r * NIN_;
#pragma unroll
        for (int p = 0; p < 4; ++p) {
            u32x4* ptr = (u32x4*)zr + p * 64 + lane;
            const u32x4 v = *ptr; float s = 0.f;
#pragma unroll
            for (int e = 0; e < 4; ++e) { const float a = bf_lo(v[e]), b = bf_hi(v[e]); s += a * a + b * b; }
            s += shx(s, 1); s += shx(s, 2); s += shx(s, 4); s += shx(s, 8);
            const float rstd = (p < 2 ? 0.08838834764831845f : 1.0f) / sqrtf(s * (1.0f / 128.0f) + EPS_);
            const float* g = (p < 2 ? gq : gk) + li * 8;
            const f32x4 g0 = *(const f32x4*)g, g1 = *(const f32x4*)(g + 4); u32x4 w;
            w.x = cvt_pk_bf16(bf_lo(v.x) * rstd * g0[0], bf_hi(v.x) * rstd * g0[1]); w.y = cvt_pk_bf16(bf_lo(v.y) * rstd * g0[2], bf_hi(v.y) * rstd * g0[3]);
            w.z = cvt_pk_bf16(bf_lo(v.z) * rstd * g1[0], bf_hi(v.z) * rstd * g1[1]); w.w = cvt_pk_bf16(bf_lo(v.w) * rstd * g1[2], bf_hi(v.w) * rstd * g1[3]);
            *ptr = w;
        }
        u32x4* vp = (u32x4*)(zr + 4096) + lane;
        u32x4 v[2]; float f[16]; float s = 0.f;
#pragma unroll
        for (int i = 0; i < 2; ++i) { v[i] = vp[64 * i];
#pragma unroll
            for (int e = 0; e < 4; ++e) { f[i * 8 + 2 * e] = bf_lo(v[i][e]); f[i * 8 + 2 * e + 1] = bf_hi(v[i][e]); s += f[i * 8 + 2 * e] + f[i * 8 + 2 * e + 1]; } }
        const float mu = wave_sum(s) * (1.0f / 1024.0f); float q = 0.f;
#pragma unroll
        for (int e = 0; e < 16; ++e) { f[e] -= mu; q += f[e] * f[e]; }
        const float rstd = 1.0f / sqrtf(wave_sum(q) * (1.0f / 1024.0f) + EPS_);
#pragma unroll
        for (int i = 0; i < 2; ++i) { const int c0 = (lane + 64 * i) * 8; u32x4 w;
            const f32x4 g0 = *(const f32x4*)(lng + c0), g1 = *(const f32x4*)(lng + c0 + 4), b0 = *(const f32x4*)(lnb + c0), b1 = *(const f32x4*)(lnb + c0 + 4);
            w.x = cvt_pk_bf16(f[i * 8 + 0] * rstd * g0[0] + b0[0], f[i * 8 + 1] * rstd * g0[1] + b0[1]); w.y = cvt_pk_bf16(f[i * 8 + 2] * rstd * g0[2] + b0[2], f[i * 8 + 3] * rstd * g0[3] + b0[3]);
            w.z = cvt_pk_bf16(f[i * 8 + 4] * rstd * g1[0] + b1[0], f[i * 8 + 5] * rstd * g1[1] + b1[1]); w.w = cvt_pk_bf16(f[i * 8 + 6] * rstd * g1[2] + b1[2], f[i * 8 + 7] * rstd * g1[3] + b1[3]);
            vp[64 * i] = w; }
    }
}
__device__ __forceinline__ void ynorm_rows(bf16_t* Y, const float* ga, const float* gb, int gw, int NGW, int lane) {
    const int hf = lane >> 5, li = lane & 31; const float* g = hf ? gb : ga;
    for (int r = gw; r < S_; r += 2 * NGW) {
        u32x4* yp0 = (u32x4*)(Y + (size_t)r * 2048 + hf * 1024) + li; u32x4* yp1 = (u32x4*)(Y + (size_t)(r + NGW) * 2048 + hf * 1024) + li;
        u32x4 v[2][4]; float s[2] = {0.f, 0.f};
#pragma unroll
        for (int i = 0; i < 4; ++i) { v[0][i] = yp0[32 * i]; v[1][i] = yp1[32 * i]; }
#pragma unroll
        for (int k = 0; k < 2; ++k) {
#pragma unroll
            for (int i = 0; i < 4; ++i)
#pragma unroll
                for (int e = 0; e < 4; ++e) { const float a = bf_lo(v[k][i][e]), b = bf_hi(v[k][i][e]); s[k] += a * a + b * b; }
            s[k] += shx(s[k], 1); s[k] += shx(s[k], 2); s[k] += shx(s[k], 4); s[k] += shx(s[k], 8); s[k] += shx(s[k], 16);
            s[k] = 1.0f / sqrtf(s[k] * (1.0f / 1024.0f) + EPS_); }
#pragma unroll
        for (int i = 0; i < 4; ++i) { const int c0 = (li + 32 * i) * 8; const f32x4 g0 = *(const f32x4*)(g + c0), g1 = *(const f32x4*)(g + c0 + 4);
#pragma unroll
            for (int k = 0; k < 2; ++k) { const float rstd = s[k]; const u32x4 q = v[k][i]; u32x4 w;
                w.x = cvt_pk_bf16(bf_lo(q.x) * rstd * g0[0], bf_hi(q.x) * rstd * g0[1]); w.y = cvt_pk_bf16(bf_lo(q.y) * rstd * g0[2], bf_hi(q.y) * rstd * g0[3]);
                w.z = cvt_pk_bf16(bf_lo(q.z) * rstd * g1[0], bf_hi(q.z) * rstd * g1[1]); w.w = cvt_pk_bf16(bf_lo(q.w) * rstd * g1[2], bf_hi(q.w) * rstd * g1[3]);
                (k ? yp1 : yp0)[32 * i] = w; } }
    }
}
__device__ __forceinline__ void softmax_rows(const float* SC, bf16_t* P, int gw, int NGW, int lane) {
    const int h = lane >> 4, li = lane & 15;
    for (int r = gw; r < S_; r += NGW) {
        const f32x4* sp = (const f32x4*)(SC + (size_t)r * 1024 + h * 256) + li;
        f32x4 v[4]; float mx = -1e30f;
#pragma unroll
        for (int i = 0; i < 4; ++i) { v[i] = sp[16 * i]; mx = fmaxf(mx, fmaxf(fmaxf(v[i][0], v[i][1]), fmaxf(v[i][2], v[i][3]))); }
        mx = fmaxf(mx, shx(mx, 1)); mx = fmaxf(mx, shx(mx, 2)); mx = fmaxf(mx, shx(mx, 4)); mx = fmaxf(mx, shx(mx, 8));
        float s = 0.f;
#pragma unroll
        for (int i = 0; i < 4; ++i)
#pragma unroll
            for (int e = 0; e < 4; ++e) { v[i][e] = fast_exp(v[i][e] - mx); s += v[i][e]; }
        s += shx(s, 1); s += shx(s, 2); s += shx(s, 4); s += shx(s, 8);
        const float inv = 1.0f / s;
        u32x2* pp = (u32x2*)(P + (size_t)r * 1024 + h * 256) + li;
#pragma unroll
        for (int i = 0; i < 4; ++i) { u32x2 w; w.x = cvt_pk_bf16(v[i][0] * inv, v[i][1] * inv); w.y = cvt_pk_bf16(v[i][2] * inv, v[i][3] * inv); pp[16 * i] = w; }
    }
}

struct TDesc { const float* src; bf16_t* dst; const float* gk; int N, K; };
__device__ __forceinline__ void t_load(const TDesc& d, int lane, f32x4 (&v)[8], f32x4 (&gv)[2]) {
    const int q = lane & 7, kr = lane >> 3;
#pragma unroll
    for (int j = 0; j < 8; ++j) v[j] = *(const f32x4*)(d.src + (size_t)(8 * j + kr) * d.N + 4 * q);
    if (d.gk) { gv[0] = *(const f32x4*)(d.gk + 8 * q); gv[1] = *(const f32x4*)(d.gk + 8 * q + 4); } else { gv[0] = (f32x4){1.f, 1.f, 1.f, 1.f}; gv[1] = gv[0]; }
}
__device__ __forceinline__ void t_store(const TDesc& d, int lane, const f32x4 (&v)[8], const f32x4 (&gv)[2], LAS float* scr) {
    const int q = lane & 7, kr = lane >> 3;
#pragma unroll
    for (int j = 0; j < 8; ++j) { LAS float* w = scr + (8 * j + kr) * 33 + 4 * q; w[0] = v[j][0]; w[1] = v[j][1]; w[2] = v[j][2]; w[3] = v[j][3]; }
    asm volatile("s_waitcnt lgkmcnt(0)" ::: "memory");
    const int c = q;
#pragma unroll
    for (int j = 0; j < 4; ++j) { const int n = (lane >> 3) + 8 * j; const LAS float* s = scr + (8 * c) * 33 + n;
        u32x4 o; o.x = cvt_pk_bf16(s[0 * 33] * gv[0][0], s[1 * 33] * gv[0][1]); o.y = cvt_pk_bf16(s[2 * 33] * gv[0][2], s[3 * 33] * gv[0][3]);
        o.z = cvt_pk_bf16(s[4 * 33] * gv[1][0], s[5 * 33] * gv[1][1]); o.w = cvt_pk_bf16(s[6 * 33] * gv[1][2], s[7 * 33] * gv[1][3]);
        *(u32x4*)(d.dst + (size_t)n * d.K + 8 * c) = o; }
    asm volatile("s_waitcnt lgkmcnt(0)" ::: "memory");
}
template <int MODE> __device__ __forceinline__ void t_desc(TDesc& d, const float* W, int K, int N, bf16_t* WT, const float* gk, int item) {
    const int nblk = N / 32, kb = item / nblk, nb = item % nblk, n0 = 32 * nb, k0 = 64 * kb;
    int drow0 = n0;
    if (MODE == 1) { const int j0 = n0 < FF_ ? n0 : n0 - FF_; drow0 = (j0 >> 7) * 256 + (j0 & 127) + (n0 < FF_ ? 0 : 128); }
    d.src = W + (size_t)k0 * N + n0; d.dst = WT + (size_t)drow0 * K + k0; d.gk = gk ? gk + k0 : nullptr; d.N = N; d.K = K;
}

constexpr int AT_KS = 0, AT_VT = 17408, AT_TB = 35840;
__device__ __forceinline__ void attn_unit(LAS unsigned char* lds, const bf16_t* Z, bf16_t* Y, float* ys, const float* rel_l, const float* gq, const float* gk, int h, int qg, int tid, int wid, int lane) {
    const int fr = lane & 15, fq = lane >> 4;
    const int R0 = qg * 256, cw = 4 * qg + (wid >> 1);
    __syncthreads();
    LAS float* tb = (LAS float*)(lds + AT_TB);
    for (int i = tid; i < 832; i += 512) tb[i] = rel_l[h * 513 + (i < 512 ? i : 512)];
    bf16x8 Qf[2][4];
#pragma unroll
    for (int qt = 0; qt < 2; ++qt)
#pragma unroll
        for (int ks = 0; ks < 4; ++ks) Qf[qt][ks] = *(const bf16x8*)(Z + (size_t)(R0 + 32 * wid + 16 * qt + fr) * NIN_ + h * 128 + 32 * ks + 8 * fq);
    float rq[2];
#pragma unroll
    for (int qt = 0; qt < 2; ++qt) { float t = 0.f;
#pragma unroll
        for (int ks = 0; ks < 4; ++ks) { const u32x4 w = __builtin_bit_cast(u32x4, Qf[qt][ks]);
#pragma unroll
            for (int e = 0; e < 4; ++e) { const float a = bf_lo(w[e]), b = bf_hi(w[e]); t += a * a + b * b; } }
        t += shx(t, 16); t += shx(t, 32); rq[qt] = 1.0f / sqrtf(t * (1.0f / 128.0f) + EPS_); }
    LAS float* gqk = (LAS float*)(lds + AT_TB + 3328);
    if (tid < 128) gqk[tid] = gq[tid] * gk[tid] * 0.08838834764831845f;
    f32x4 O[8][2];
#pragma unroll
    for (int dt = 0; dt < 8; ++dt) { O[dt][0] = (f32x4){0.f, 0.f, 0.f, 0.f}; O[dt][1] = (f32x4){0.f, 0.f, 0.f, 0.f}; }
    float m_run[2] = {-1e30f, -1e30f}, l_run[2] = {0.f, 0.f};
    const int kc_lo = (4 * qg - 8) > 0 ? (4 * qg - 8) : 0, kc_hi = 4 * qg + 3;
    u32x4 kreg[2], vreg[2];
    const char* Zc = (const char*)Z;
    unsigned koff[2], voff_[2];
#pragma unroll
    for (int i = 0; i < 2; ++i) { const int c = tid + 512 * i; koff[i] = (unsigned)(((c >> 4) * NIN_ + 1024 + h * 128 + (c & 15) * 8) * 2); voff_[i] = (unsigned)(((c >> 4) * NIN_ + 2048 + h * 128 + (c & 15) * 8) * 2); }
#define AT_LOAD(kc) do { const char* zk = Zc + (size_t)(kc) * (size_t)(64 * NIN_ * 2); _Pragma("unroll") for (int i = 0; i < 2; ++i) { \
        kreg[i] = *(const u32x4*)(zk + koff[i]); vreg[i] = *(const u32x4*)(zk + voff_[i]); } } while (0)
    AT_LOAD(kc_lo);
    for (int kc = kc_lo; kc <= kc_hi; ++kc) {
        __syncthreads();
#pragma unroll
        for (int i = 0; i < 2; ++i) { const int c = tid + 512 * i;
            {   float f[8]; float t = 0.f;
#pragma unroll
                for (int e = 0; e < 4; ++e) { f[2 * e] = bf_lo(kreg[i][e]); f[2 * e + 1] = bf_hi(kreg[i][e]); t += f[2 * e] * f[2 * e] + f[2 * e + 1] * f[2 * e + 1]; }
                t += shx(t, 1); t += shx(t, 2); t += shx(t, 4); t += shx(t, 8);
                const float rk = 1.0f / sqrtf(t * (1.0f / 128.0f) + EPS_);
                const f32x4 g0 = *(const LAS f32x4*)(gqk + (c & 15) * 8) * rk, g1 = *(const LAS f32x4*)(gqk + (c & 15) * 8 + 4) * rk;
                u32x4 kw; kw.x = cvt_pk_bf16(f[0] * g0[0], f[1] * g0[1]); kw.y = cvt_pk_bf16(f[2] * g0[2], f[3] * g0[3]);
                kw.z = cvt_pk_bf16(f[4] * g1[0], f[5] * g1[1]); kw.w = cvt_pk_bf16(f[6] * g1[2], f[7] * g1[3]);
                *(LAS u32x4*)(lds + AT_KS + (c >> 4) * 272 + (c & 15) * 16) = kw; }
            *(LAS u32x4*)(lds + AT_VT + (c >> 4) * 288 + (c & 15) * 16) = vreg[i]; }
        __syncthreads();
        if (kc < kc_hi) AT_LOAD(kc + 1);
        if (kc >= cw - 8 && kc <= cw) {
            f32x4 st[2][4];
#pragma unroll
            for (int nt = 0; nt < 4; ++nt) {
                st[0][nt] = (f32x4){0.f, 0.f, 0.f, 0.f}; st[1][nt] = (f32x4){0.f, 0.f, 0.f, 0.f};
                bf16x8 kf[4];
#pragma unroll
                for (int ks = 0; ks < 4; ++ks) kf[ks] = *(const LAS bf16x8*)(lds + AT_KS + (16 * nt + fr) * 272 + (32 * ks + 8 * fq) * 2);
#pragma unroll
                for (int ks = 0; ks < 4; ++ks) { st[0][nt] = __builtin_amdgcn_mfma_f32_16x16x32_bf16(kf[ks], Qf[0][ks], st[0][nt], 0, 0, 0); st[1][nt] = __builtin_amdgcn_mfma_f32_16x16x32_bf16(kf[ks], Qf[1][ks], st[1][nt], 0, 0, 0); }
                __builtin_amdgcn_sched_barrier(0);
            }
            bf16x8 pf[2][2];
#pragma unroll
            for (int qt = 0; qt < 2; ++qt) {
                const LAS float* tbq = tb + ((cw - kc) * 64 + 32 * (wid & 1) + 16 * qt + fr - 4 * fq + 256 - 63);
                float mx = -1e30f;
#pragma unroll
                for (int nt = 0; nt < 4; ++nt)
#pragma unroll
                    for (int jj = 0; jj < 4; ++jj) { const float s = st[qt][nt][jj] * rq[qt] + tbq[63 - 16 * nt - jj]; st[qt][nt][jj] = s; mx = fmaxf(mx, s); }
                mx = fmaxf(mx, shx(mx, 16)); mx = fmaxf(mx, shx(mx, 32));
                const float m_new = fmaxf(m_run[qt], mx), alpha = fast_exp(m_run[qt] - m_new);
                float sum = 0.f;
#pragma unroll
                for (int nt = 0; nt < 4; ++nt)
#pragma unroll
                    for (int jj = 0; jj < 4; ++jj) { const float p = fast_exp(st[qt][nt][jj] - m_new); st[qt][nt][jj] = p; sum += p; }
                sum += shx(sum, 16); sum += shx(sum, 32);
                l_run[qt] = l_run[qt] * alpha + sum; m_run[qt] = m_new;
#pragma unroll
                for (int dt = 0; dt < 8; ++dt) O[dt][qt] = O[dt][qt] * alpha;
#pragma unroll
                for (int k2 = 0; k2 < 2; ++k2) { u32x4 w; w.x = cvt_pk_bf16(st[qt][2 * k2][0], st[qt][2 * k2][1]); w.y = cvt_pk_bf16(st[qt][2 * k2][2], st[qt][2 * k2][3]);
                    w.z = cvt_pk_bf16(st[qt][2 * k2 + 1][0], st[qt][2 * k2 + 1][1]); w.w = cvt_pk_bf16(st[qt][2 * k2 + 1][2], st[qt][2 * k2 + 1][3]); pf[qt][k2] = __builtin_bit_cast(bf16x8, w); }
            }
            __builtin_amdgcn_sched_barrier(0);
            const unsigned vtb = (unsigned)(__SIZE_TYPE__)(lds + AT_VT) + (unsigned)((4 * fq + (fr >> 2)) * 288 + (fr & 3) * 8);
#define AT_TR(dst, OFF) asm volatile("ds_read_b64_tr_b16 %0, %1 offset:%2" : "=&v"(dst) : "v"(vtb), "i"(OFF) : "memory")
#pragma unroll
            for (int dp = 0; dp < 4; ++dp) {
                u32x2 lo[2][2], hi[2][2];
#pragma unroll
                for (int dd = 0; dd < 2; ++dd)
#pragma unroll
                    for (int k2 = 0; k2 < 2; ++k2) { AT_TR(lo[dd][k2], (2 * dp + dd) * 32 + k2 * 32 * 288); AT_TR(hi[dd][k2], (2 * dp + dd) * 32 + k2 * 32 * 288 + 16 * 288); }
                asm volatile("s_waitcnt lgkmcnt(0)" ::: "memory"); __builtin_amdgcn_sched_barrier(0);
#pragma unroll
                for (int dd = 0; dd < 2; ++dd)
#pragma unroll
                    for (int k2 = 0; k2 < 2; ++k2) { const int dt = 2 * dp + dd;
                        u32x4 w; w.x = lo[dd][k2].x; w.y = lo[dd][k2].y; w.z = hi[dd][k2].x; w.w = hi[dd][k2].y; const bf16x8 vf = __builtin_bit_cast(bf16x8, w);
                        O[dt][0] = __builtin_amdgcn_mfma_f32_16x16x32_bf16(vf, pf[0][k2], O[dt][0], 0, 0, 0); O[dt][1] = __builtin_amdgcn_mfma_f32_16x16x32_bf16(vf, pf[1][k2], O[dt][1], 0, 0, 0); }
                __builtin_amdgcn_sched_barrier(0);
            }
#undef AT_TR
        }
    }
#undef AT_LOAD
#pragma unroll
    for (int qt = 0; qt < 2; ++qt) { const float inv = 1.0f / l_run[qt]; const int row = R0 + 32 * wid + 16 * qt + fr; bf16_t* yr = Y + (size_t)row * 2048 + h * 128 + 4 * fq; float sq = 0.f;
#pragma unroll
        for (int dt = 0; dt < 8; ++dt) { const f32x4 o = O[dt][qt] * inv; sq += (o[0] * o[0] + o[1] * o[1]) + (o[2] * o[2] + o[3] * o[3]); u32x2 w; w.x = cvt_pk_bf16(o[0], o[1]); w.y = cvt_pk_bf16(o[2], o[3]); *(u32x2*)(yr + 16 * dt) = w; }
        sq += shx(sq, 16); sq += shx(sq, 32); ys[(size_t)row * 16 + h] = sq; }
}

constexpr int GM_RS = 528;
__device__ __forceinline__ void gmlp2_unit(LAS unsigned char* lds, const bf16_t* Z, bf16_t* Y, float* ys, const bf16_t* Wsm_l, const float* bs_l, const float* vs, const float* lng, const float* lnb, int nb, int gp, int tid, int wid, int lane) {
    const int fr = lane & 15, fq = lane >> 4;
    __syncthreads();
    {   const int t = tid & 127;
        const f32x4* sp = (const f32x4*)(vs + (size_t)(nb * 128 + t) * 32);
        float s1 = 0.f, s2 = 0.f;
#pragma unroll
        for (int i = 0; i < 8; ++i) { const f32x4 q = sp[i]; s1 += q[0] + q[2]; s2 += q[1] + q[3]; }
        const float mu = s1 * (1.0f / 1024.0f), rstd = 1.0f / sqrtf(fmaxf(s2 * (1.0f / 1024.0f) - mu * mu, 0.f) + EPS_);
        const bf16_t* zr = Z + (size_t)(nb * 128 + t) * NIN_ + 4096 + gp * 256;
        u32x4 v[8];
#pragma unroll
        for (int i = 0; i < 8; ++i) v[i] = *(const u32x4*)(zr + ((tid >> 7) + 4 * i) * 8);
#pragma unroll
        for (int i = 0; i < 8; ++i) { const int dch = (tid >> 7) + 4 * i;
            const float* gpn = lng + gp * 256 + dch * 8; const float* bpn = lnb + gp * 256 + dch * 8;
            const f32x4 g0 = *(const f32x4*)gpn, g1 = *(const f32x4*)(gpn + 4), b0 = *(const f32x4*)bpn, b1 = *(const f32x4*)(bpn + 4);
            u32x4 w;
            w.x = cvt_pk_bf16((bf_lo(v[i].x) - mu) * rstd * g0[0] + b0[0], (bf_hi(v[i].x) - mu) * rstd * g0[1] + b0[1]); w.y = cvt_pk_bf16((bf_lo(v[i].y) - mu) * rstd * g0[2] + b0[2], (bf_hi(v[i].y) - mu) * rstd * g0[3] + b0[3]);
            w.z = cvt_pk_bf16((bf_lo(v[i].z) - mu) * rstd * g1[0] + b1[0], (bf_hi(v[i].z) - mu) * rstd * g1[1] + b1[1]); w.w = cvt_pk_bf16((bf_lo(v[i].w) - mu) * rstd * g1[2] + b1[2], (bf_hi(v[i].w) - mu) * rstd * g1[3] + b1[3]);
            *(LAS u32x4*)(lds + t * GM_RS + dch * 16) = w; } }
    const int row = nb * 128 + 16 * wid + fr;
    const unsigned gtb = (unsigned)(__SIZE_TYPE__)lds + (unsigned)((8 * fq + (fr >> 2)) * GM_RS + (fr & 3) * 8);
    __syncthreads();
#pragma unroll
    for (int g2 = 0; g2 < 2; ++g2) {
        const int g = 2 * gp + g2;
        bf16x8 wsf[4];
#pragma unroll
        for (int ks = 0; ks < 4; ++ks) wsf[ks] = *(const bf16x8*)(Wsm_l + (size_t)(g * 128 + 16 * wid + fr) * 128 + 32 * ks + 8 * fq);
        const float bs = bs_l[g * 128 + 16 * wid + fr]; float ysq = 0.f;
        u32x2 uu[8];
#pragma unroll
        for (int ct = 0; ct < 8; ++ct) uu[ct] = *(const u32x2*)(Z + (size_t)row * NIN_ + 3072 + g * 128 + 16 * ct + 4 * fq);
#pragma unroll
        for (int ct = 0; ct < 8; ++ct) {
            f32x4 acc = (f32x4){0.f, 0.f, 0.f, 0.f};
            {   u32x2 lo[4], hi[4];
#pragma unroll
                for (int ks = 0; ks < 4; ++ks) {
                    asm volatile("ds_read_b64_tr_b16 %0, %1 offset:%2" : "=&v"(lo[ks]) : "v"(gtb), "i"(ks * 32 * GM_RS + g2 * 256 + ct * 32) : "memory");
                    asm volatile("ds_read_b64_tr_b16 %0, %1 offset:%2" : "=&v"(hi[ks]) : "v"(gtb), "i"(ks * 32 * GM_RS + 4 * GM_RS + g2 * 256 + ct * 32) : "memory"); }
                asm volatile("s_waitcnt lgkmcnt(0)" ::: "memory"); __builtin_amdgcn_sched_barrier(0);
#pragma unroll
                for (int ks = 0; ks < 4; ++ks) { u32x4 w; w.x = lo[ks].x; w.y = lo[ks].y; w.z = hi[ks].x; w.w = hi[ks].y; acc = __builtin_amdgcn_mfma_f32_16x16x32_bf16(__builtin_bit_cast(bf16x8, w), wsf[ks], acc, 0, 0, 0); }
            }
            const float y0 = bf_lo(uu[ct].x) * (acc[0] + bs), y1 = bf_hi(uu[ct].x) * (acc[1] + bs), y2 = bf_lo(uu[ct].y) * (acc[2] + bs), y3 = bf_hi(uu[ct].y) * (acc[3] + bs);
            ysq += (y0 * y0 + y1 * y1) + (y2 * y2 + y3 * y3);
            u32x2 w; w.x = cvt_pk_bf16(y0, y1); w.y = cvt_pk_bf16(y2, y3);
            *(u32x2*)(Y + (size_t)row * 2048 + 1024 + g * 128 + 16 * ct + 4 * fq) = w;
        }
        ysq += shx(ysq, 16); ysq += shx(ysq, 32); ys[(size_t)row * 16 + 8 + g] = ysq;
    }
}

#define PROBE_DUP 0
#define NREP(k) ((PROBE_DUP == (k)) ? 2 : 1)
__global__ void __launch_bounds__(NWAVES * 64, 2) mega_fwd(Args a) {
    extern __shared__ __attribute__((aligned(16))) unsigned char lds_raw[];
    LAS unsigned char* lds = (LAS unsigned char*)lds_raw;
    cg::grid_group grid = cg::this_grid();
    int tid = threadIdx.x, lane = tid & 63, wid = __builtin_amdgcn_readfirstlane(tid >> 6);
    const int G = (int)gridDim.x, NGW = G * NWAVES; int gw = (int)blockIdx.x * NWAVES + wid;
#define PHASE_BEGIN() do { tid = threadIdx.x; asm volatile("" : "+v"(tid)); lane = tid & 63; wid = __builtin_amdgcn_readfirstlane(tid >> 6); gw = (int)blockIdx.x * NWAVES + wid; } while (0)
    unsigned char* const ws = a.ws;
#define XN ((bf16_t*)(ws + WS_XN))
#define HB ((bf16_t*)(ws + WS_H))
#define ZB ((bf16_t*)(ws + WS_H))
#define YB ((bf16_t*)(ws + WS_Y))
#define QM ((bf16_t*)(ws + WS_Y))
#define SC ((float*)(ws + WS_H))
#define PB ((bf16_t*)(ws + WS_H + H_OFF_P))
#define WKV ((bf16_t*)(ws + WS_WKV))
#define WSM ((bf16_t*)(ws + WS_WSM))
#define AMEM ((bf16_t*)(ws + WS_AMEM))
#define KVALL ((bf16_t*)(ws + WS_KVALL))
#define KN ((bf16_t*)(ws + WS_KN))
#define X (a.out)
#define SS ((float*)(ws + WS_SS))
#define QS ((float*)(ws + WS_QS))
#define VS ((float*)(ws + WS_VS))
#define YS ((float*)(ws + WS_YS))
#define YS ((float*)(ws + WS_YS))

    volatile LAS unsigned* bst = (volatile LAS unsigned*)(lds + 131072 + 12288);
    if (tid == 0) { bst[0] = 0u; bst[1] = 0u; }

    {
        LAS float* scr = (LAS float*)(lds + wid * 16384);
        constexpr int I_1 = (D_ / 64) * (2 * FF_ / 32), I_2 = (FF_ / 64) * (D_ / 32), I_IN = (D_ / 64) * (NIN_ / 32), I_DD = (D_ / 64) * (D_ / 32), I_KV = (D_ / 64) * (2 * D_ / 32);
        constexpr int PER_L = 2 * I_1 + 2 * I_2 + I_IN + 3 * I_DD + I_KV;
#define T_DECODE(d, it_) do { const int l = (it_) / PER_L; int r = (it_) % PER_L; unsigned char* wl = ws + (size_t)l * LO_END; \
            if (r < I_1) { t_desc<1>(d, a.in[I_W_FFN1_IN] + (size_t)l * D_ * 2 * FF_, D_, 2 * FF_, (bf16_t*)(wl + LO_W1A), a.in[I_G_FFN1] + l * D_, r); break; } r -= I_1; \
            if (r < I_1) { t_desc<1>(d, a.in[I_W_FFN2_IN] + (size_t)l * D_ * 2 * FF_, D_, 2 * FF_, (bf16_t*)(wl + LO_W1B), a.in[I_G_FFN2] + l * D_, r); break; } r -= I_1; \
            if (r < I_2) { t_desc<0>(d, a.in[I_W_FFN1_OUT] + (size_t)l * FF_ * D_, FF_, D_, (bf16_t*)(wl + LO_W2A), nullptr, r); break; } r -= I_2; \
            if (r < I_2) { t_desc<0>(d, a.in[I_W_FFN2_OUT] + (size_t)l * FF_ * D_, FF_, D_, (bf16_t*)(wl + LO_W2B), nullptr, r); break; } r -= I_2; \
            if (r < I_IN) { t_desc<0>(d, a.in[I_W_IN] + (size_t)l * D_ * NIN_, D_, NIN_, (bf16_t*)(wl + LO_WIN), a.in[I_G_MIX] + l * D_, r); break; } r -= I_IN; \
            if (r < I_DD) { const int kb_ = r / (D_ / 32); t_desc<0>(d, a.in[I_W_OUT] + (size_t)l * D_ * D_, D_, D_, (bf16_t*)(wl + LO_WOUT), (kb_ < 16 ? a.in[I_G_OUT_A] + l * 1024 : a.in[I_G_OUT_B] + l * 1024 - 1024), r); break; } r -= I_DD; \
            if (r < I_DD) { t_desc<0>(d, a.in[I_W_MEM_Q] + (size_t)l * D_ * D_, D_, D_, (bf16_t*)(wl + LO_WQ), a.in[I_G_MEM_Q] + l * D_, r); break; } r -= I_DD; \
            if (r < I_DD) { t_desc<0>(d, a.in[I_W_MEM_O] + (size_t)l * D_ * D_, D_, D_, (bf16_t*)(wl + LO_WO), nullptr, r); break; } r -= I_DD; \
            t_desc<0>(d, a.in[I_W_MEM_KV] + (size_t)l * D_ * 2 * D_, D_, 2 * D_, WKV + (size_t)l * 2 * D_ * D_, nullptr, r); } while (0)
        for (int rep = 0; rep < NREP(1); ++rep) {
            TDesc dc, dn; f32x4 va[8], vb[8], ga[2], gb[2];
            int it = gw;
            if (it < 2 * PER_L) { T_DECODE(dc, it); t_load(dc, lane, va, ga); }
            for (; it < 2 * PER_L; it += NGW) {
                const bool more = it + NGW < 2 * PER_L;
                if (more) { T_DECODE(dn, it + NGW); t_load(dn, lane, vb, gb); }
                t_store(dc, lane, va, ga, scr);
                if (more) { dc = dn;
#pragma unroll
                    for (int j = 0; j < 8; ++j) va[j] = vb[j];
                    ga[0] = gb[0]; ga[1] = gb[1]; }
            }
        }
#undef T_DECODE
        for (int i = (int)blockIdx.x * 512 + tid; i < 2 * 8 * 128 * 128 / 2; i += G * 512) {
            const int e = 2 * i, t = e & 127, s = (e >> 7) & 127; const f32x2 w = *(const f32x2*)(a.in[I_W_S] + e);
            const bool keep = (s >> 6) >= (t >> 6);
            ((unsigned*)WSM)[i] = keep ? cvt_pk_bf16(w.x, w.y) : 0u;
        }
        for (int l = 0; l < 2; ++l) rms_rows_2048(a.in[I_MEM], a.in[I_G_MEM_KV] + l * D_, AMEM + (size_t)l * 256 * D_, 256, gw, NGW, lane);
        rows_bf16_ss(a.in[I_X], XN, SS, S_, gw, NGW, lane);
    }
    if (a.ws == nullptr) grid.sync();
    const XcdBarrier xbar = xcd_barrier_post((unsigned*)(ws + WS_BAR), bst);
#define GRID_BAR() xcd_barrier(xbar)
    GRID_BAR(); PHASE_BEGIN();
    if (PROBE_DUP == 6) { for (int i = 0; i < 10; ++i) GRID_BAR(); }

#pragma unroll
    for (int l = 0; l < 2; ++l) {
        unsigned char* wl = ws + (size_t)l * LO_END;
        const float* xin = (l == 0) ? a.in[I_X] : X;
        {   pg8::Gemm g{XN, (const bf16_t*)(wl + LO_W1A), D_, D_, D_, S_ / 256, 2 * FF_ / 256, 256u * D_ * 2u, 0, 0, 256u * D_ * 2u, 0};
            pg8::Epi<1, true> E{HB, FF_, nullptr, 1.f, 0, SS, nullptr, nullptr, nullptr, 0, 0, nullptr}; for (int rep = 0; rep < (l == 1 ? NREP(2) : 1); ++rep) pg8::gemm_phase(lds, g, E); }
        if (l == 0) {
            pg8::Gemm g{AMEM, WKV, D_, D_, D_, 2, 32, 256u * D_ * 2u, 0, 0, 256u * D_ * 2u, 64};
            pg8::Epi<0> E{KVALL, 8192, nullptr, 1.f, 1 << 30, nullptr, nullptr, nullptr, nullptr, 0, 0, nullptr}; pg8::gemm_phase(lds, g, E); }
        GRID_BAR(); PHASE_BEGIN();
        {   pg8::Gemm g{HB, (const bf16_t*)(wl + LO_W2A), FF_, FF_, FF_, S_ / 256, D_ / 256, 256u * FF_ * 2u, 0, 0, 256u * FF_ * 2u, 0};
            if (PROBE_DUP == 3 && l == 1) { pg8::Epi<2, true> E2{(float*)(ws + WS_END), D_, xin, 0.5f, 0, nullptr, YB, (float*)(ws + WS_END + (size_t)S_ * D_ * 4), nullptr, 0, 0, nullptr}; pg8::gemm_phase(lds, g, E2); }
            pg8::Epi<2, true> E{X, D_, xin, 0.5f, 0, nullptr, XN, SS, nullptr, 0, 0, nullptr}; pg8::gemm_phase(lds, g, E); }
        if (l == 0) {
            PHASE_BEGIN();
            for (int ll = 0; ll < 2; ++ll) headnorm512_rows(KVALL + (size_t)ll * 256 * 8192 + ll * 4096, 8192, KN + (size_t)ll * 256 * D_, D_, a.in[I_G_K_MEM] + ll * 512, a.in[I_G_Q_MEM] + ll * 512, 0.04419417382415922f, 256, gw, NGW, lane);
            for (int ll = 0; ll < 2; ++ll) {
                pg8::Gemm g{(const bf16_t*)(ws + (size_t)ll * LO_END + LO_WO), KVALL + (size_t)ll * 256 * 8192 + ll * 4096 + 2048, D_, 8192, 512, 8, 4, 256u * D_ * 2u, 512u * 2u, 0, 512u * 2u,ll ? 224 : 0};
                pg8::Epi<0> E{(bf16_t*)(ws + (size_t)ll * LO_END + LO_VW), 1024, nullptr, 1.f, 1 << 30, nullptr, nullptr, nullptr, nullptr, 0, 0, nullptr}; pg8::gemm_phase(lds, g, E); }
        }
        GRID_BAR(); PHASE_BEGIN();
        {   pg8::Gemm g{XN, (const bf16_t*)(wl + LO_WIN), D_, D_, D_, S_ / 256, NIN_ / 256, 256u * D_ * 2u, 0, 0, 256u * D_ * 2u, 0};
            pg8::Epi<0, true, true> E{ZB, NIN_, nullptr, 1.f, 12, SS, nullptr, nullptr, VS, 16, 16, nullptr}; for (int rep = 0; rep < (l == 1 ? NREP(4) : 1); ++rep) pg8::gemm_phase(lds, g, E); }
        GRID_BAR(); PHASE_BEGIN();
#ifndef NO_ATTN
        for (int rep = 0; rep < (l == 1 ? NREP(5) : 1); ++rep)
        for (int it = (int)blockIdx.x; it < 512 + 512; it += G) {
            if (it < 512) attn_unit(lds, ZB, YB, YS, a.in[I_REL] + (size_t)l * 8 * 513, a.in[I_G_Q_A] + l * 128, a.in[I_G_K_A] + l * 128, it & 7, it >> 3, tid, wid, lane);
            else { const int j = it - 512; gmlp2_unit(lds, ZB, YB, YS, WSM + (size_t)l * 8 * 128 * 128, a.in[I_B_S] + l * 1024, VS, a.in[I_LN_G] + l * 1024, a.in[I_LN_B] + l * 1024, j >> 2, j & 3, tid, wid, lane); }
        }
#endif
        GRID_BAR(); PHASE_BEGIN();
        {   pg8::Gemm g{YB, (const bf16_t*)(wl + LO_WOUT), D_, D_, D_, S_ / 256, D_ / 256, 256u * D_ * 2u, 0, 0, 256u * D_ * 2u, 0};
            pg8::Epi<5> E{X, D_, X, 1.0f, 0, YS, XN, SS, nullptr, 0, 0, nullptr}; pg8::gemm_phase(lds, g, E); }
        GRID_BAR(); PHASE_BEGIN();
        {   pg8::Gemm g{XN, (const bf16_t*)(wl + LO_WQ), D_, D_, D_, S_ / 256, D_ / 256, 256u * D_ * 2u, 0, 0, 256u * D_ * 2u, 0};
            pg8::Epi<0, true, true> E{QM, D_, nullptr, 1.f, 1 << 30, SS, nullptr, nullptr, QS, 32, 0, nullptr}; pg8::gemm_phase(lds, g, E); }
        GRID_BAR(); PHASE_BEGIN();
        {   pg8::Gemm g{QM, KN + (size_t)l * 256 * D_, D_, D_, 512, S_ / 256, 4, 256u * D_ * 2u, 512u * 2u, 0, 512u * 2u, 0};
            pg8::Epi<4> E{PB, 1024, nullptr, 1.f, 0, QS, nullptr, nullptr, nullptr, 0, 0, lds + 131072}; pg8::gemm_phase(lds, g, E); }
        GRID_BAR(); PHASE_BEGIN();
        {   pg8::Gemm g{PB, (const bf16_t*)(wl + LO_VW), 1024, 1024, 1024, S_ / 256, D_ / 256, 256u * 1024u * 2u, 0, 0, 256u * 1024u * 2u, 0};
            pg8::Epi<2, true> E{X, D_, X, 1.0f, 0, nullptr, XN, SS, nullptr, 0, 0, nullptr}; pg8::gemm_phase(lds, g, E); }
        GRID_BAR(); PHASE_BEGIN();
        {   pg8::Gemm g{XN, (const bf16_t*)(wl + LO_W1B), D_, D_, D_, S_ / 256, 2 * FF_ / 256, 256u * D_ * 2u, 0, 0, 256u * D_ * 2u, 0};
            pg8::Epi<1, true> E{HB, FF_, nullptr, 1.f, 0, SS, nullptr, nullptr, nullptr, 0, 0, nullptr}; pg8::gemm_phase(lds, g, E); }
        GRID_BAR(); PHASE_BEGIN();
        {   pg8::Gemm g{HB, (const bf16_t*)(wl + LO_W2B), FF_, FF_, FF_, S_ / 256, D_ / 256, 256u * FF_ * 2u, 0, 0, 256u * FF_ * 2u, 0};
            if (l == 0) { pg8::Epi<2, true> E{X, D_, X, 0.5f, 0, nullptr, XN, SS, nullptr, 0, 0, nullptr}; pg8::gemm_phase(lds, g, E); }
            else { pg8::Epi<2, false> E{X, D_, X, 0.5f, 0, nullptr, nullptr, nullptr, nullptr, 0, 0, nullptr}; pg8::gemm_phase(lds, g, E); } }
        if (l == 0) { GRID_BAR(); PHASE_BEGIN(); }
    }
}

extern "C" void kernel_launch(void* const* d_in, const int* in_sizes, int n_in, void* d_out, int out_size, void* d_ws, size_t ws_size, hipStream_t stream) {
    static int grid = 0;
    if (grid == 0) {
        if (n_in != 27 || out_size != S_ * D_ || ws_size < WS_END + (size_t)S_ * D_ * 4 + (size_t)S_ * 128) { fprintf(stderr, "kernel_launch: unexpected shapes (n_in %d out %d ws %zu need %zu)\n", n_in, out_size, ws_size, (size_t)WS_END); grid = -1; return; }
        int dev = 0, cus = 0, per_cu = 0;
        hipGetDevice(&dev);
        hipDeviceGetAttribute(&cus, hipDeviceAttributeMultiprocessorCount, dev);
        if (hipFuncSetAttribute((const void*)mega_fwd, hipFuncAttributeMaxDynamicSharedMemorySize, LDS_BYTES) != hipSuccess) { fprintf(stderr, "kernel_launch: hipFuncSetAttribute failed\n"); grid = -1; return; }
        if (hipOccupancyMaxActiveBlocksPerMultiprocessor(&per_cu, (const void*)mega_fwd, NWAVES * 64, LDS_BYTES) != hipSuccess || per_cu < 1) { fprintf(stderr, "kernel_launch: occupancy query gave %d\n", per_cu); per_cu = 1; }
        (void)hipGetLastError();
        grid = cus * per_cu;
    }
    if (grid < 0) return;
    Args a{};
    for (int i = 0; i < 27; ++i) a.in[i] = (const float*)d_in[i];
    a.out = (float*)d_out; a.ws = (unsigned char*)d_ws;
    void* args[] = {&a};
    if (hipMemsetAsync((unsigned char*)d_ws + WS_BAR, 0, 16384, stream) != hipSuccess) { fprintf(stderr, "kernel_launch: hipMemsetAsync of the barrier words failed\n"); return; }
    hipError_t e = hipLaunchCooperativeKernel((const void*)mega_fwd, dim3(grid), dim3(NWAVES * 64), args, LDS_BYTES, stream);
    if (e != hipSuccess) fprintf(stderr, "kernel_launch: cooperative launch failed: %s (grid %d)\n", hipGetErrorString(e), grid);
}
```

```cpp
#include <hip/hip_runtime.h>
#include <hip/hip_cooperative_groups.h>
#include <cstdio>
#include <cstdint>
namespace cg = cooperative_groups;

#define LAS __attribute__((address_space(3)))
typedef unsigned short bf16_t;
typedef short bf16x8 __attribute__((ext_vector_type(8)));
typedef float f32x4 __attribute__((ext_vector_type(4)));
typedef float f32x2 __attribute__((ext_vector_type(2)));
typedef unsigned u32x4 __attribute__((ext_vector_type(4)));
typedef unsigned u32x2 __attribute__((ext_vector_type(2)));

constexpr int S_ = 16384, D_ = 2048, FF_ = 5504, NIN_ = 5120, NMEM_ = 256;
constexpr float EPS_ = 1e-6f;
constexpr int NWAVES = 8;
constexpr int LDS_BYTES = 147456;

constexpr size_t SZ_W1 = (size_t)2 * FF_ * D_ * 2, SZ_W2 = (size_t)D_ * FF_ * 2, SZ_WIN = (size_t)NIN_ * D_ * 2, SZ_DD = (size_t)D_ * D_ * 2, SZ_WKV = (size_t)2 * D_ * D_ * 2;
constexpr size_t LO_W1A = 0, LO_W2A = LO_W1A + SZ_W1, LO_WIN = LO_W2A + SZ_W2, LO_WOUT = LO_WIN + SZ_WIN, LO_WQ = LO_WOUT + SZ_DD, LO_WO = LO_WQ + SZ_DD,
                 LO_W1B = LO_WO + SZ_DD, LO_W2B = LO_W1B + SZ_W1, LO_VW = LO_W2B + SZ_W2, LO_END = LO_VW + (size_t)D_ * 1024 * 2;
constexpr size_t WS_WKV = 2 * LO_END, WS_WSM = WS_WKV + 2 * SZ_WKV, WS_AMEM = WS_WSM + (size_t)2 * 8 * 128 * 128 * 2, WS_KVALL = WS_AMEM + (size_t)512 * 2048 * 2,
                 WS_KN = WS_KVALL + (size_t)512 * 8192 * 2, WS_XN = WS_KN + (size_t)2 * 256 * 2048 * 2, WS_H = WS_XN + (size_t)S_ * D_ * 2, WS_Y = WS_H + (size_t)S_ * FF_ * 2,
                 WS_SS = WS_Y + (size_t)S_ * D_ * 2, WS_BAR = WS_SS + (size_t)S_ * 32 * 4, WS_QS = WS_BAR + 16384, WS_VS = WS_QS + (size_t)S_ * 32 * 8, WS_YS = WS_VS + (size_t)S_ * 16 * 8, WS_GQK = WS_YS + (size_t)S_ * 16 * 4, WS_END = WS_GQK + 1024;
constexpr size_t H_OFF_P = (size_t)80 << 20;

__device__ __forceinline__ unsigned cvt_pk_bf16(float lo, float hi) { unsigned r; asm("v_cvt_pk_bf16_f32 %0, %1, %2" : "=v"(r) : "v"(lo), "v"(hi)); return r; }
__device__ __forceinline__ float bf_lo(unsigned u) { return __uint_as_float(u << 16); }
__device__ __forceinline__ float bf_hi(unsigned u) { return __uint_as_float(u & 0xffff0000u); }
__device__ __forceinline__ float fast_exp(float x) { return __builtin_amdgcn_exp2f(x * 1.44269504089f); }
__device__ __forceinline__ float silu_f(float a) { return a * __builtin_amdgcn_rcpf(1.0f + fast_exp(-a)); }
__device__ __forceinline__ float gelu_f(float x) { const float y = 1.5957691216f * (x + 0.044715f * x * x * x); return x * __builtin_amdgcn_rcpf(1.0f + fast_exp(-y)); }
__device__ __forceinline__ float shx(float v, int m) {
    int l_ = (int)__builtin_amdgcn_mbcnt_hi(~0u, __builtin_amdgcn_mbcnt_lo(~0u, 0u)); asm volatile("" : "+v"(l_)); const int idx = (l_ ^ m) << 2;
    return __builtin_bit_cast(float, __builtin_amdgcn_ds_bpermute(idx, __builtin_bit_cast(int, v)));
}
__device__ __forceinline__ float wave_sum(float v) {
#pragma unroll
    for (int o = 1; o < 64; o <<= 1) v += shx(v, o);
    return v;
}

namespace pg8 {
constexpr int BM = 256, BK = 64, HALF = 128, HTB = HALF * BK * 2, STAGE_BYTES = 8 * HTB, NXCD = 8, WGM = 8;
__host__ __device__ __forceinline__ int lds_byte(int r, int c) { const int st = (r >> 4) * 2 + (c >> 5), rr = r & 15, cc = c & 31, ob = rr * 64 + cc * 2; return st * 1024 + (ob ^ (((ob >> 9) & 1) << 5)); }
__host__ __device__ __forceinline__ void stage_rc(int b, int& R, int& C) { const int st = b / 1024, sb = b % 1024, swz = sb ^ (((sb >> 9) & 1) << 5); R = (st >> 1) * 16 + swz / 64; C = (st & 1) * 32 + (swz % 64) / 2; }
__host__ __device__ __forceinline__ int perm32(int rho) { const int n = rho >> 4, i = rho & 15; return 8 * (i >> 2) + 4 * n + (i & 3); }

struct Unit { int pm, pn; };
struct Gemm { const bf16_t* A; const bf16_t* Bt; int lda, ldb, K, nM, nN; unsigned a_pm, a_pn, b_pm, b_pn; int bx_off; };

struct StaticOrder {
    int nM, nN, nwg, G, c;
    __device__ void init(int nM_, int nN_, int G_, int c_) { nM = nM_; nN = nN_; nwg = nM * nN; G = G_; c = c_; }
    __device__ bool next(int i, Unit& u) const {
        const int L = i * G + c; if (L >= nwg) return false;
        int wgid = L; { const int q = nwg / NXCD, r = nwg % NXCD, xcd = wgid % NXCD, off = wgid / NXCD; wgid = (xcd < r ? xcd * (q + 1) : r * (q + 1) + (xcd - r) * q) + off; }
        const int nig = WGM * nN, gid = wgid / nig, fm = gid * WGM, gsz = (nM - fm) < WGM ? (nM - fm) : WGM;
        u.pm = fm + ((wgid % nig) % gsz); u.pn = (wgid % nig) / gsz; return true;
    }
};

template <int MODE, bool FLAG = false, bool STATS = false, bool HN = false> struct Epi {
    static constexpr bool MIDK = (MODE == 5);
    void* out; int ldc; const float* base; float scale; int gelu_pn; const float* ss; bf16_t* xb; float* sso; float* st; int st_n, st_pn0; LAS unsigned char* xch;
    __device__ __forceinline__ void row_vars(const Unit& u, int ai, int wr, int fr, int fq, float (&va)[4], float (&vb)[4]) const {
        const int row0 = u.pm * BM + wr * 64 + fr + ai * HALF; f32x4 q[4];
#pragma unroll
        for (int m = 0; m < 4; ++m) q[m] = *(const f32x4*)(ss + (size_t)(row0 + m * 16) * 16 + 4 * fq);
#pragma unroll
        for (int m = 0; m < 4; ++m) { float t = (q[m][0] + q[m][1]) + (q[m][2] + q[m][3]); t += shx(t, 16); const float o = shx(t, 32);
            va[m] = (fq < 2 ? t : o) * (1.0f / 1024.0f) + EPS_; vb[m] = (fq < 2 ? o : t) * (1.0f / 1024.0f) + EPS_; }
    }
    __device__ __forceinline__ void midk_factors(float (&fm)[2][4], const Unit& u, int wr, int fr, int fq) const {
#pragma unroll
        for (int ai = 0; ai < 2; ++ai) {
            float va[4], vb[4]; row_vars(u, ai, wr, fr, fq, va, vb);
#pragma unroll
            for (int m = 0; m < 4; ++m) fm[ai][m] = sqrtf(vb[m] / va[m]);
        }
    }
    __device__ __forceinline__ void operator()(const f32x4 (&acc)[2][2][4][2], const Unit& u, int wr, int wc, int fr, int fq) const {
        const int row0 = u.pm * BM + wr * 64 + fr;
        float rs[2][4];
        if constexpr (MODE == 0 || MODE == 1) {
#pragma unroll
            for (int ai = 0; ai < 2; ++ai)
#pragma unroll
                for (int m = 0; m < 4; ++m) rs[ai][m] = 1.0f;
            if constexpr (FLAG) {
                f32x4 x0[2][4], x1[2][4];
#pragma unroll
                for (int ai = 0; ai < 2; ++ai)
#pragma unroll
                    for (int m = 0; m < 4; ++m) { const float* p = ss + (size_t)(row0 + ai * HALF + m * 16) * 32 + fq * 8; x0[ai][m] = *(const f32x4*)p; x1[ai][m] = *(const f32x4*)(p + 4); }
#pragma unroll
                for (int ai = 0; ai < 2; ++ai)
#pragma unroll
                    for (int m = 0; m < 4; ++m) {
                        float t = ((x0[ai][m][0] + x0[ai][m][1]) + (x0[ai][m][2] + x0[ai][m][3])) + ((x1[ai][m][0] + x1[ai][m][1]) + (x1[ai][m][2] + x1[ai][m][3])); t += shx(t, 16); t += shx(t, 32);
                        rs[ai][m] = 1.0f / sqrtf(t * (1.0f / 2048.0f) + EPS_); }
            }
        }
        if constexpr (MODE == 1) {
            bf16_t* O = (bf16_t*)out; const int col0 = u.pn * HALF + wc * 32 + 8 * fq;
#pragma unroll
            for (int ai = 0; ai < 2; ++ai)
#pragma unroll
                for (int m = 0; m < 4; ++m) {
                    const float r = rs[ai][m];
                    const f32x4 a0 = acc[ai][0][m][0] * r, a1 = acc[ai][0][m][1] * r, b0 = acc[ai][1][m][0] * r, b1 = acc[ai][1][m][1] * r;
                    u32x4 w;
                    w.x = cvt_pk_bf16(silu_f(a0[0]) * b0[0], silu_f(a0[1]) * b0[1]); w.y = cvt_pk_bf16(silu_f(a0[2]) * b0[2], silu_f(a0[3]) * b0[3]);
                    w.z = cvt_pk_bf16(silu_f(a1[0]) * b1[0], silu_f(a1[1]) * b1[1]); w.w = cvt_pk_bf16(silu_f(a1[2]) * b1[2], silu_f(a1[3]) * b1[3]);
                    *(u32x4*)(O + (size_t)(row0 + ai * HALF + m * 16) * ldc + col0) = w;
                }
        } else if constexpr (MODE == 2 || MODE == 5) {
            constexpr bool XBF = FLAG || MODE == 5;
            const int col0 = u.pn * BM + wc * 32 + 8 * fq;
#pragma unroll
            for (int ai = 0; ai < 2; ++ai) {
                float rb5[4] = {1.f, 1.f, 1.f, 1.f};
                if constexpr (MODE == 5) { float va[4], vb[4]; row_vars(u, ai, wr, fr, fq, va, vb);
#pragma unroll
                    for (int m = 0; m < 4; ++m) rb5[m] = 1.0f / sqrtf(vb[m]); }
                f32x4 bs[4][2][2];
#pragma unroll
                for (int m = 0; m < 4; ++m)
#pragma unroll
                    for (int bj = 0; bj < 2; ++bj) { const float* bp = base + (size_t)(row0 + ai * HALF + m * 16) * ldc + col0 + bj * HALF; bs[m][bj][0] = *(const f32x4*)bp; bs[m][bj][1] = *(const f32x4*)(bp + 4); }
#pragma unroll
                for (int m = 0; m < 4; ++m) {
                    const size_t roff = (size_t)(row0 + ai * HALF + m * 16) * ldc + col0;
                    float sq = 0.f;
#pragma unroll
                    for (int bj = 0; bj < 2; ++bj) {
                        const float sc = (MODE == 5) ? rb5[m] : scale;
                        const f32x4 x0 = bs[m][bj][0] + acc[ai][bj][m][0] * sc, x1 = bs[m][bj][1] + acc[ai][bj][m][1] * sc;
                        *(f32x4*)((float*)out + roff + bj * HALF) = x0; *(f32x4*)((float*)out + roff + bj * HALF + 4) = x1;
                        if constexpr (XBF) {
                            u32x4 w; w.x = cvt_pk_bf16(x0[0], x0[1]); w.y = cvt_pk_bf16(x0[2], x0[3]); w.z = cvt_pk_bf16(x1[0], x1[1]); w.w = cvt_pk_bf16(x1[2], x1[3]);
                            *(u32x4*)(xb + roff + bj * HALF) = w;
                            sq += ((x0[0] * x0[0] + x0[1] * x0[1]) + (x0[2] * x0[2] + x0[3] * x0[3])) + ((x1[0] * x1[0] + x1[1] * x1[1]) + (x1[2] * x1[2] + x1[3] * x1[3]));
                        }
                    }
                    if constexpr (XBF) { sq += shx(sq, 16); sq += shx(sq, 32); sso[(size_t)(row0 + ai * HALF + m * 16) * 32 + u.pn * 4 + wc] = sq; }
                }
            }
        } else if constexpr (MODE == 4) {
            float rq[2][4], mw[2][4], sw[2][4];
            {   f32x4 q4[2][4];
#pragma unroll
                for (int ai = 0; ai < 2; ++ai)
#pragma unroll
                    for (int m = 0; m < 4; ++m) q4[ai][m] = *(const f32x4*)(ss + ((size_t)(row0 + ai * HALF + m * 16) * 32 + 8 * u.pn + 2 * fq) * 2);
#pragma unroll
                for (int ai = 0; ai < 2; ++ai)
#pragma unroll
                    for (int m = 0; m < 4; ++m) { float t = q4[ai][m][1] + q4[ai][m][3]; t += shx(t, 16); t += shx(t, 32); rq[ai][m] = 1.0f / sqrtf(t * (1.0f / 512.0f) + EPS_); } }
            typedef float f32x2v __attribute__((ext_vector_type(2)));
            LAS f32x2v* X2 = (LAS f32x2v*)xch;
#pragma unroll
            for (int ai = 0; ai < 2; ++ai)
#pragma unroll
                for (int m = 0; m < 4; ++m) {
                    const float r = rq[ai][m]; float mx = -1e30f;
#pragma unroll
                    for (int bj = 0; bj < 2; ++bj)
#pragma unroll
                        for (int n = 0; n < 2; ++n)
#pragma unroll
                            for (int e = 0; e < 4; ++e) mx = fmaxf(mx, acc[ai][bj][m][n][e] * r);
                    mx = fmaxf(mx, shx(mx, 16)); mx = fmaxf(mx, shx(mx, 32));
                    float sm = 0.f;
#pragma unroll
                    for (int bj = 0; bj < 2; ++bj)
#pragma unroll
                        for (int n = 0; n < 2; ++n)
#pragma unroll
                            for (int e = 0; e < 4; ++e) sm += fast_exp(acc[ai][bj][m][n][e] * r - mx);
                    sm += shx(sm, 16); sm += shx(sm, 32);
                    mw[ai][m] = mx; sw[ai][m] = sm;
                    X2[(ai * HALF + wr * 64 + m * 16 + fr) * 4 + wc] = (f32x2v){mx, sm};
                }
            asm volatile("s_waitcnt lgkmcnt(0)" ::: "memory"); __builtin_amdgcn_s_barrier(); asm volatile("" ::: "memory");
            bf16_t* O = (bf16_t*)out; const int col0 = u.pn * BM + wc * 32 + 8 * fq;
#pragma unroll
            for (int ai = 0; ai < 2; ++ai)
#pragma unroll
                for (int m = 0; m < 4; ++m) {
                    const LAS f32x4* xp = (const LAS f32x4*)(X2 + (ai * HALF + wr * 64 + m * 16 + fr) * 4);
                    const f32x4 p0 = xp[0], p1 = xp[1];
                    const float M = fmaxf(fmaxf(p0[0], p0[2]), fmaxf(p1[0], p1[2]));
                    const float tot = (p0[1] * fast_exp(p0[0] - M) + p0[3] * fast_exp(p0[2] - M)) + (p1[1] * fast_exp(p1[0] - M) + p1[3] * fast_exp(p1[2] - M));
                    const float r = rq[ai][m], mo = mw[ai][m], f = fast_exp(mo - M) / tot;
#pragma unroll
                    for (int bj = 0; bj < 2; ++bj) {
                        const f32x4 v0 = acc[ai][bj][m][0], v1 = acc[ai][bj][m][1]; u32x4 w;
                        w.x = cvt_pk_bf16(fast_exp(v0[0] * r - mo) * f, fast_exp(v0[1] * r - mo) * f); w.y = cvt_pk_bf16(fast_exp(v0[2] * r - mo) * f, fast_exp(v0[3] * r - mo) * f);
                        w.z = cvt_pk_bf16(fast_exp(v1[0] * r - mo) * f, fast_exp(v1[1] * r - mo) * f); w.w = cvt_pk_bf16(fast_exp(v1[2] * r - mo) * f, fast_exp(v1[3] * r - mo) * f);
                        *(u32x4*)(O + (size_t)(row0 + ai * HALF + m * 16) * ldc + col0 + bj * HALF) = w;
                    }
                }
            (void)sw;
        } else {
            const int col0 = u.pn * BM + wc * 32 + 8 * fq;
            if constexpr (MODE == 0 && HN) {
                if (u.pn < 8) {
                    LAS float* X = (LAS float*)xch + (wr * 64 + fr) * 8 + wc;
#pragma unroll
                    for (int ai = 0; ai < 2; ++ai)
#pragma unroll
                        for (int m = 0; m < 4; ++m)
#pragma unroll
                            for (int bj = 0; bj < 2; ++bj) { const f32x4 v0 = acc[ai][bj][m][0] * rs[ai][m], v1 = acc[ai][bj][m][1] * rs[ai][m];
                                float t = ((v0[0] * v0[0] + v0[1] * v0[1]) + (v0[2] * v0[2] + v0[3] * v0[3])) + ((v1[0] * v1[0] + v1[1] * v1[1]) + (v1[2] * v1[2] + v1[3] * v1[3]));
                                t += shx(t, 16); t += shx(t, 32); X[(ai * HALF + m * 16) * 8 + bj * 4] = t; }
                    asm volatile("s_waitcnt lgkmcnt(0)" ::: "memory"); __builtin_amdgcn_s_barrier(); asm volatile("" ::: "memory");
                    f32x4 g0 = (f32x4){1.f, 1.f, 1.f, 1.f}, g1 = g0;
                    if (u.pn >= 4) { g0 = *(const f32x4*)(base + wc * 32 + 8 * fq); g1 = *(const f32x4*)(base + wc * 32 + 8 * fq + 4); }
#pragma unroll
                    for (int ai = 0; ai < 2; ++ai)
#pragma unroll
                        for (int m = 0; m < 4; ++m) {
                            const size_t roff = (size_t)(row0 + ai * HALF + m * 16) * ldc + col0;
#pragma unroll
                            for (int bj = 0; bj < 2; ++bj) { const f32x4 p = *(const LAS f32x4*)((LAS float*)xch + (wr * 64 + fr + ai * HALF + m * 16) * 8 + bj * 4);
                                const float r = rs[ai][m] / sqrtf(((p[0] + p[1]) + (p[2] + p[3])) * (1.0f / 128.0f) + EPS_);
                                const f32x4 v0 = acc[ai][bj][m][0] * r * g0, v1 = acc[ai][bj][m][1] * r * g1;
                                u32x4 w; w.x = cvt_pk_bf16(v0[0], v0[1]); w.y = cvt_pk_bf16(v0[2], v0[3]); w.z = cvt_pk_bf16(v1[0], v1[1]); w.w = cvt_pk_bf16(v1[2], v1[3]);
                                *(u32x4*)((bf16_t*)out + roff + bj * HALF) = w; }
                        }
                    return;
                }
            }
            const bool do_gelu = (MODE == 0) && (u.pn >= gelu_pn);
#pragma unroll
            for (int ai = 0; ai < 2; ++ai)
#pragma unroll
                for (int m = 0; m < 4; ++m) {
                    const size_t roff = (size_t)(row0 + ai * HALF + m * 16) * ldc + col0;
                    float s1 = 0.f, s2 = 0.f;
#pragma unroll
                    for (int bj = 0; bj < 2; ++bj) {
                        f32x4 v0 = acc[ai][bj][m][0], v1 = acc[ai][bj][m][1];
                        if constexpr (MODE == 0) {
                            v0 = v0 * rs[ai][m]; v1 = v1 * rs[ai][m];
                            if (do_gelu) {
#pragma unroll
                                for (int e = 0; e < 4; ++e) { v0[e] = gelu_f(v0[e]); v1[e] = gelu_f(v1[e]); }
                            }
                            if constexpr (STATS) {
                                s1 += ((v0[0] + v0[1]) + (v0[2] + v0[3])) + ((v1[0] + v1[1]) + (v1[2] + v1[3]));
                                s2 += ((v0[0] * v0[0] + v0[1] * v0[1]) + (v0[2] * v0[2] + v0[3] * v0[3])) + ((v1[0] * v1[0] + v1[1] * v1[1]) + (v1[2] * v1[2] + v1[3] * v1[3]));
                            }
                            u32x4 w; w.x = cvt_pk_bf16(v0[0], v0[1]); w.y = cvt_pk_bf16(v0[2], v0[3]); w.z = cvt_pk_bf16(v1[0], v1[1]); w.w = cvt_pk_bf16(v1[2], v1[3]);
                            *(u32x4*)((bf16_t*)out + roff + bj * HALF) = w;
                        } else {
                            *(f32x4*)((float*)out + roff + bj * HALF) = v0 * scale; *(f32x4*)((float*)out + roff + bj * HALF + 4) = v1 * scale;
                        }
                    }
                    if constexpr (MODE == 0 && STATS) {
                        s1 += shx(s1, 16); s1 += shx(s1, 32); s2 += shx(s2, 16); s2 += shx(s2, 32);
                        if (u.pn >= st_pn0) *(f32x2*)(st + ((size_t)(row0 + ai * HALF + m * 16) * st_n + 4 * (u.pn - st_pn0) + wc) * 2) = (f32x2){s1, s2};
                    }
                }
        }
    }
};

template <class EpiT>
__device__ __forceinline__ void gemm_phase(LAS unsigned char* lds, const Gemm g, const EpiT& E) {
    int tid = threadIdx.x; asm volatile("" : "+v"(tid));
    const int wid = __builtin_amdgcn_readfirstlane(tid >> 6), lane = tid & 63, wr = wid >> 2, wc = wid & 3, fr = lane & 15, fq = lane >> 4;
    constexpr int KS = EpiT::MIDK ? 2 : 1;
    const int K = g.K, nt = K / BK / KS;
    const unsigned segstep = (unsigned)(nt * BK * 2);
    int bx_ = (int)((blockIdx.x + (unsigned)g.bx_off) % gridDim.x); asm volatile("" : "+s"(bx_));
    StaticOrder S; S.init(g.nM, g.nN, (int)gridDim.x, bx_);
    unsigned voffA[2], voffB[2];
#pragma unroll
    for (int i = 0; i < 2; ++i) { int R, C; stage_rc(tid * 16 + i * 8192, R, C); const int Rb = (R & ~31) + perm32(R & 31);
        voffA[i] = (unsigned)(R * g.lda + C) * 2u; voffB[i] = (unsigned)(Rb * g.ldb + C) * 2u; }
    const size_t kstep = (size_t)(BK * 2);
    const unsigned hstepA = (unsigned)HALF * g.lda * 2u, hstepB = (unsigned)HALF * g.ldb * 2u;
    const unsigned ldsw = (unsigned)wid * 1024u;
    const int aoff = lds_byte(wr * 64 + fr, fq * 8), boff = lds_byte(wc * 32 + fr, fq * 8);
#define PG8_SA(b, h) (((b) * 2 + (h)) * HTB)
#define PG8_SB(b, h) ((4 + (b) * 2 + (h)) * HTB)
#define PG8_STAGE(bufoff, gbase, voff) do { _Pragma("unroll") for (int _i = 0; _i < 2; ++_i) \
        __builtin_amdgcn_global_load_lds((const unsigned*)((const char*)(gbase) + (voff)[_i]), (LAS unsigned*)(lds + (bufoff) + ldsw + _i * 8192), 16, 0, 0); } while (0)
#define PG8_LDA(dst, b, h) do { _Pragma("unroll") for (int m = 0; m < 4; ++m) _Pragma("unroll") for (int k = 0; k < 2; ++k) dst[m][k] = *(const LAS bf16x8*)(lds + PG8_SA(b, h) + aoff + m * 2048 + k * 1024); } while (0)
#define PG8_LDB(dst, b, h) do { _Pragma("unroll") for (int n = 0; n < 2; ++n) _Pragma("unroll") for (int k = 0; k < 2; ++k) dst[n][k] = *(const LAS bf16x8*)(lds + PG8_SB(b, h) + boff + n * 2048 + k * 1024); } while (0)
#define PG8_MMA(ai, bj, At, Bt) do { __builtin_amdgcn_s_setprio(1); _Pragma("unroll") for (int m = 0; m < 4; ++m) _Pragma("unroll") for (int n = 0; n < 2; ++n) _Pragma("unroll") for (int k = 0; k < 2; ++k) \
        acc[ai][bj][m][n] = __builtin_amdgcn_mfma_f32_16x16x32_bf16(Bt[n][k], At[m][k], acc[ai][bj][m][n], 0, 0, 0); __builtin_amdgcn_s_setprio(0); } while (0)
#define PG8_WAIT_V(n) asm volatile("s_waitcnt vmcnt(" #n ")" ::: "memory")
#define PG8_WAIT_L(n) asm volatile("s_waitcnt lgkmcnt(" #n ")" ::: "memory")
#define PG8_BAR __builtin_amdgcn_s_barrier()
#define PG8_SCHED __builtin_amdgcn_sched_barrier(0)
    Unit cur, nxt; int ui = 0;
    if (!S.next(0, cur)) return;
    f32x4 acc[2][2][4][2];
#pragma unroll
    for (int a = 0; a < 2; ++a)
#pragma unroll
        for (int b = 0; b < 2; ++b)
#pragma unroll
            for (int m = 0; m < 4; ++m)
#pragma unroll
                for (int n = 0; n < 2; ++n) acc[a][b][m][n] = (f32x4){0.f, 0.f, 0.f, 0.f};
    bf16x8 At[4][2], B0[2][2], B1[2][2];
    const char* cA = (const char*)g.A + (size_t)((unsigned)cur.pm * g.a_pm + (unsigned)cur.pn * g.a_pn); const char* cB = (const char*)g.Bt + (size_t)((unsigned)cur.pm * g.b_pm + (unsigned)cur.pn * g.b_pn);
    PG8_STAGE(PG8_SB(0, 0), cB, voffB); PG8_STAGE(PG8_SB(0, 1), cB + hstepB, voffB); PG8_STAGE(PG8_SA(0, 0), cA, voffA); PG8_STAGE(PG8_SA(0, 1), cA + hstepA, voffA);
    if (wr == 1) PG8_BAR;
    PG8_WAIT_V(2); PG8_BAR;
    PG8_STAGE(PG8_SB(1, 0), cB + kstep, voffB); PG8_STAGE(PG8_SA(1, 0), cA + kstep, voffA); PG8_STAGE(PG8_SB(1, 1), cB + hstepB + kstep, voffB);
    PG8_WAIT_V(6); PG8_BAR;
    for (;;) {
        const bool seg0 = (KS == 2) && ((ui & 1) == 0);
        bool has_next; const char* nA; const char* nB;
        if (seg0) { has_next = true; nxt = cur; nA = cA + segstep; nB = cB + segstep; }
        else {
            has_next = S.next((ui + 1) / KS, nxt);
            nA = has_next ? (const char*)g.A + (size_t)((unsigned)nxt.pm * g.a_pm + (unsigned)nxt.pn * g.a_pn) : cA;
            nB = has_next ? (const char*)g.Bt + (size_t)((unsigned)nxt.pm * g.b_pm + (unsigned)nxt.pn * g.b_pn) : cB;
        }
        for (int t = 0; t < nt; t += 2) {
            const bool last = (t == nt - 2);
            const char* a1 = cA + (size_t)(t + 1) * kstep;
            const char* a2 = last ? nA : cA + (size_t)(t + 2) * kstep; const char* b2 = last ? nB : cB + (size_t)(t + 2) * kstep;
            const char* a3 = a2 + kstep; const char* b3 = b2 + kstep;
            PG8_LDB(B0, 0, 0); PG8_LDB(B1, 0, 1); PG8_SCHED; PG8_LDA(At, 0, 0); PG8_STAGE(PG8_SA(1, 1), a1 + hstepA, voffA);
            PG8_WAIT_V(8); PG8_WAIT_L(0); PG8_BAR; PG8_MMA(0, 0, At, B0); PG8_MMA(0, 1, At, B1); PG8_BAR; PG8_SCHED;
            PG8_LDA(At, 0, 1); PG8_STAGE(PG8_SB(0, 0), b2, voffB); PG8_STAGE(PG8_SB(0, 1), b2 + hstepB, voffB); PG8_STAGE(PG8_SA(0, 0), a2, voffA);
            PG8_WAIT_V(8); PG8_WAIT_L(0); PG8_BAR; PG8_MMA(1, 0, At, B0); PG8_MMA(1, 1, At, B1); PG8_BAR; PG8_SCHED;
            PG8_LDB(B0, 1, 0); PG8_LDB(B1, 1, 1); PG8_SCHED; PG8_LDA(At, 1, 0); PG8_STAGE(PG8_SA(0, 1), a2 + hstepA, voffA);
            PG8_WAIT_V(8); PG8_WAIT_L(0); PG8_BAR; PG8_MMA(0, 0, At, B0); PG8_MMA(0, 1, At, B1); PG8_BAR; PG8_SCHED;
            PG8_LDA(At, 1, 1); PG8_STAGE(PG8_SB(1, 0), b3, voffB); PG8_STAGE(PG8_SB(1, 1), b3 + hstepB, voffB); PG8_STAGE(PG8_SA(1, 0), a3, voffA);
            PG8_WAIT_V(8); PG8_WAIT_L(0); PG8_BAR; PG8_MMA(1, 0, At, B0); PG8_MMA(1, 1, At, B1); PG8_BAR; PG8_SCHED;
        }
        const int l2_ = (int)__builtin_amdgcn_mbcnt_hi(~0u, __builtin_amdgcn_mbcnt_lo(~0u, 0u)), fr2 = l2_ & 15, fq2 = l2_ >> 4;
        Unit cu2 = cur; asm volatile("" : "+s"(cu2.pm), "+s"(cu2.pn));
        if (!seg0) {
            if (wr == 0) PG8_BAR;
            E(acc, cu2, wr, wc, fr2, fq2);
            if (!has_next) break;
        }
        if constexpr (EpiT::MIDK) {
            float fm[2][4];
#pragma unroll
            for (int ai = 0; ai < 2; ++ai)
#pragma unroll
                for (int m = 0; m < 4; ++m) fm[ai][m] = 0.f;
            if (seg0) E.midk_factors(fm, cu2, wr, fr2, fq2);
#pragma unroll
            for (int ai = 0; ai < 2; ++ai)
#pragma unroll
                for (int bj = 0; bj < 2; ++bj)
#pragma unroll
                    for (int m = 0; m < 4; ++m)
#pragma unroll
                        for (int n = 0; n < 2; ++n) acc[ai][bj][m][n] = acc[ai][bj][m][n] * fm[ai][m];
        } else {
#pragma unroll
            for (int a = 0; a < 2; ++a)
#pragma unroll
                for (int b = 0; b < 2; ++b)
#pragma unroll
                    for (int m = 0; m < 4; ++m)
#pragma unroll
                        for (int n = 0; n < 2; ++n) acc[a][b][m][n] = (f32x4){0.f, 0.f, 0.f, 0.f};
        }
        cur = nxt; cA = nA; cB = nB; ++ui;
        if (!seg0) { if (wr == 1) PG8_BAR; }
    }
    PG8_WAIT_V(0);
    PG8_BAR;
#undef PG8_SA
#undef PG8_SB
#undef PG8_STAGE
#undef PG8_LDA
#undef PG8_LDB
#undef PG8_MMA
#undef PG8_WAIT_V
#undef PG8_WAIT_L
#undef PG8_BAR
#undef PG8_SCHED
}
}

#define XB_TMO      128
#define XB_XCNT(j)  (256  + 64 * (j))
#define XB_XSUB(j)  (1280 + 64 * (j))
#define XB_XGEN(j)  (2304 + 64 * (j))
#define XB_TOP      3328
#define XB_TOPGEN   3392
#define XCD_BAR_WORDS 3456
#define XB_SPIN_CAP (1u << 20)
__device__ __forceinline__ unsigned xb_ld(unsigned* p)              { return __hip_atomic_load(p, __ATOMIC_RELAXED, __HIP_MEMORY_SCOPE_AGENT); }
__device__ __forceinline__ unsigned xb_add(unsigned* p, unsigned v) { return __hip_atomic_fetch_add(p, v, __ATOMIC_RELAXED, __HIP_MEMORY_SCOPE_AGENT); }
__device__ __forceinline__ unsigned xb_xcc_id() { return (unsigned)__builtin_amdgcn_s_getreg((3 << 11) | 20) & 0xFu; }
#define XB_SPIN(cond, bar) do { unsigned _sp = 0; while (cond) { __builtin_amdgcn_s_sleep(1); \
    if ((++_sp & 255u) == 0u) { if (xb_ld(&(bar)[XB_TMO])) break; if (_sp > XB_SPIN_CAP) { atomicAdd(&(bar)[XB_TMO], 1u); break; } } } } while (0)
struct XcdBarrier { unsigned* bar; unsigned x; volatile LAS unsigned* st; };
__device__ __forceinline__ XcdBarrier xcd_barrier_post(unsigned* bar, volatile LAS unsigned* st) {
    XcdBarrier b; b.bar = bar; b.x = (unsigned)__builtin_amdgcn_readfirstlane((int)xb_xcc_id()); b.st = st;
    if (threadIdx.x == 0) (void)xb_add(&bar[XB_XCNT(b.x)], 1u);
    return b;
}
__device__ __forceinline__ void xcd_barrier_complete(unsigned* bar, unsigned x, unsigned& nloc, unsigned& nx) {
    const unsigned G = gridDim.x * gridDim.y * gridDim.z;
    unsigned sum, cnt, mine, sp = 0u;
    for (;;) {
        sum = 0u; cnt = 0u;
#pragma unroll 1
        for (unsigned j = 0; j < 16; ++j) { const unsigned c = xb_ld(&bar[XB_XCNT(j)]); sum += c; cnt += (c > 0u) ? 1u : 0u; }
        mine = xb_ld(&bar[XB_XCNT(x)]);
        if (sum == G) break;
        __builtin_amdgcn_s_sleep(1);
        if ((++sp & 255u) == 0u) { if (xb_ld(&bar[XB_TMO])) break; if (sp > XB_SPIN_CAP) { atomicAdd(&bar[XB_TMO], 1u); break; } }
    }
    nloc = mine > 0u ? mine : 1u; nx = cnt > 0u ? cnt : 1u;
}
__device__ __forceinline__ void xcd_barrier(const XcdBarrier& b) {
    asm volatile("s_waitcnt vmcnt(0)" ::: "memory");
    __syncthreads();
    if (threadIdx.x == 0) {
        unsigned* bar = b.bar; unsigned bx = b.x; asm volatile("" : "+s"(bx));
        __builtin_amdgcn_s_waitcnt(0);
        unsigned nloc = b.st[0], nx = b.st[1];
        if (nloc == 0u) { xcd_barrier_complete(bar, bx, nloc, nx); b.st[0] = nloc; b.st[1] = nx; }
        const unsigned old = xb_add(&bar[XB_XSUB(bx)], 1u);
        const unsigned gen = old / nloc;
        if (old + 1u == (gen + 1u) * nloc) {
            __builtin_amdgcn_fence(__ATOMIC_RELEASE, "agent");
            asm volatile("s_waitcnt vmcnt(0)" ::: "memory");
            const unsigned og = xb_add(&bar[XB_TOP], 1u);
            const unsigned tg = og / nx;
            if (og + 1u == (tg + 1u) * nx) xb_add(&bar[XB_TOPGEN], 1u);
            else XB_SPIN(xb_ld(&bar[XB_TOPGEN]) == tg, bar);
            __builtin_amdgcn_fence(__ATOMIC_ACQUIRE, "agent");
            xb_add(&bar[XB_XGEN(bx)], 1u);
            asm volatile("s_waitcnt vmcnt(0)" ::: "memory");
        } else {
            XB_SPIN(xb_ld(&bar[XB_XGEN(bx)]) == gen, bar);
            __builtin_amdgcn_fence(__ATOMIC_ACQUIRE, "agent");
            asm volatile("s_waitcnt vmcnt(0)" ::: "memory");
        }
    }
    __syncthreads();
}

struct Args { const float* in[27]; float* out; unsigned char* ws; };
enum { I_X = 0, I_MEM, I_G_FFN1, I_W_FFN1_IN, I_W_FFN1_OUT, I_G_MIX, I_W_IN, I_G_Q_A, I_G_K_A, I_REL, I_LN_G, I_LN_B, I_W_S, I_B_S, I_G_OUT_A, I_G_OUT_B, I_W_OUT,
       I_G_MEM_Q, I_G_MEM_KV, I_W_MEM_Q, I_W_MEM_KV, I_W_MEM_O, I_G_Q_MEM, I_G_K_MEM, I_G_FFN2, I_W_FFN2_IN, I_W_FFN2_OUT };

__device__ __forceinline__ void rms_rows_2048(const float* x, const float* g, bf16_t* o, int nrows, int gw, int NGW, int lane) {
    for (int r = gw; r < nrows; r += NGW) {
        const f32x4* xr = (const f32x4*)(x + (size_t)r * 2048) + lane;
        f32x4 v[8]; float s = 0.f;
#pragma unroll
        for (int j = 0; j < 8; ++j) { v[j] = xr[64 * j]; s += (v[j][0] * v[j][0] + v[j][1] * v[j][1]) + (v[j][2] * v[j][2] + v[j][3] * v[j][3]); }
        const float rstd = 1.0f / sqrtf(wave_sum(s) * (1.0f / 2048.0f) + EPS_);
        u32x2* op = (u32x2*)(o + (size_t)r * 2048) + lane;
#pragma unroll
        for (int j = 0; j < 8; ++j) { const f32x4 gv = ((const f32x4*)g)[lane + 64 * j]; u32x2 w; w.x = cvt_pk_bf16(v[j][0] * rstd * gv[0], v[j][1] * rstd * gv[1]); w.y = cvt_pk_bf16(v[j][2] * rstd * gv[2], v[j][3] * rstd * gv[3]); op[64 * j] = w; }
    }
}
__device__ __forceinline__ void rows_bf16_ss(const float* x, bf16_t* o, float* ss, int nrows, int gw, int NGW, int lane) {
    for (int r = gw; r < nrows; r += 2 * NGW) {
        const f32x4* xr0 = (const f32x4*)(x + (size_t)r * 2048) + lane; const f32x4* xr1 = (const f32x4*)(x + (size_t)(r + NGW) * 2048) + lane;
        u32x2* op0 = (u32x2*)(o + (size_t)r * 2048) + lane; u32x2* op1 = (u32x2*)(o + (size_t)(r + NGW) * 2048) + lane; float s0 = 0.f, s1 = 0.f;
        f32x4 v0[8], v1[8];
#pragma unroll
        for (int j = 0; j < 8; ++j) { v0[j] = xr0[64 * j]; v1[j] = xr1[64 * j]; }
#pragma unroll
        for (int j = 0; j < 8; ++j) { const f32x4 a = v0[j], b = v1[j]; s0 += (a[0] * a[0] + a[1] * a[1]) + (a[2] * a[2] + a[3] * a[3]); s1 += (b[0] * b[0] + b[1] * b[1]) + (b[2] * b[2] + b[3] * b[3]);
            u32x2 w; w.x = cvt_pk_bf16(a[0], a[1]); w.y = cvt_pk_bf16(a[2], a[3]); op0[64 * j] = w; w.x = cvt_pk_bf16(b[0], b[1]); w.y = cvt_pk_bf16(b[2], b[3]); op1[64 * j] = w; }
        s0 = wave_sum(s0); s1 = wave_sum(s1);
        if (lane < 32) { ss[(size_t)r * 32 + lane] = (lane == 0) ? s0 : 0.f; ss[(size_t)(r + NGW) * 32 + lane] = (lane == 0) ? s1 : 0.f; }
    }
}
__device__ __forceinline__ void headnorm512_rows(const bf16_t* src, int lds_, bf16_t* dst, int ldd, const float* g, const float* g2, float scale, int nrows, int gw, int NGW, int lane) {
    const int h = lane >> 4, li = lane & 15;
    for (int r = gw; r < nrows; r += NGW) {
        const u32x4* sp = (const u32x4*)(src + (size_t)r * lds_ + h * 512) + li;
        u32x4 v[4]; float s = 0.f;
#pragma unroll
        for (int i = 0; i < 4; ++i) { v[i] = sp[16 * i];
#pragma unroll
            for (int e = 0; e < 4; ++e) { const float a = bf_lo(v[i][e]), b = bf_hi(v[i][e]); s += a * a + b * b; } }
        s += shx(s, 1); s += shx(s, 2); s += shx(s, 4); s += shx(s, 8);
        const float rstd = scale / sqrtf(s * (1.0f / 512.0f) + EPS_);
        u32x4* dp = (u32x4*)(dst + (size_t)r * ldd + h * 512) + li;
#pragma unroll
        for (int i = 0; i < 4; ++i) { f32x4 g0 = *(const f32x4*)(g + (li + 16 * i) * 8), g1 = *(const f32x4*)(g + (li + 16 * i) * 8 + 4); u32x4 w;
            if (g2) { g0 = g0 * *(const f32x4*)(g2 + (li + 16 * i) * 8); g1 = g1 * *(const f32x4*)(g2 + (li + 16 * i) * 8 + 4); }
            w.x = cvt_pk_bf16(bf_lo(v[i].x) * rstd * g0[0], bf_hi(v[i].x) * rstd * g0[1]); w.y = cvt_pk_bf16(bf_lo(v[i].y) * rstd * g0[2], bf_hi(v[i].y) * rstd * g0[3]);
            w.z = cvt_pk_bf16(bf_lo(v[i].z) * rstd * g1[0], bf_hi(v[i].z) * rstd * g1[1]); w.w = cvt_pk_bf16(bf_lo(v[i].w) * rstd * g1[2], bf_hi(v[i].w) * rstd * g1[3]);
            dp[16 * i] = w; }
    }
}
__device__ __forceinline__ void zpost_rows(bf16_t* Z, const float* gq, const float* gk, const float* lng, const float* lnb, int gw, int NGW, int lane) {
    const int li = lane & 15;
    for (int r = gw; r < S_; r += NGW) {
        bf16_t* zr = Z + (size_t)r * NIN_;
#pragma unroll
        for (int p = 0; p < 4; ++p) {
            u32x4* ptr = (u32x4*)zr + p * 64 + lane;
            const u32x4 v = *ptr; float s = 0.f;
#pragma unroll
            for (int e = 0; e < 4; ++e) { const float a = bf_lo(v[e]), b = bf_hi(v[e]); s += a * a + b * b; }
            s += shx(s, 1); s += shx(s, 2); s += shx(s, 4); s += shx(s, 8);
            const float rstd = (p < 2 ? 0.08838834764831845f : 1.0f) / sqrtf(s * (1.0f / 128.0f) + EPS_);
            const float* g = (p < 2 ? gq : gk) + li * 8;
            const f32x4 g0 = *(const f32x4*)g, g1 = *(const f32x4*)(g + 4); u32x4 w;
            w.x = cvt_pk_bf16(bf_lo(v.x) * rstd * g0[0], bf_hi(v.x) * rstd * g0[1]); w.y = cvt_pk_bf16(bf_lo(v.y) * rstd * g0[2], bf_hi(v.y) * rstd * g0[3]);
            w.z = cvt_pk_bf16(bf_lo(v.z) * rstd * g1[0], bf_hi(v.z) * rstd * g1[1]); w.w = cvt_pk_bf16(bf_lo(v.w) * rstd * g1[2], bf_hi(v.w) * rstd * g1[3]);
            *ptr = w;
        }
        u32x4* vp = (u32x4*)(zr + 4096) + lane;
        u32x4 v[2]; float f[16]; float s = 0.f;
#pragma unroll
        for (int i = 0; i < 2; ++i) { v[i] = vp[64 * i];
#pragma unroll
            for (int e = 0; e < 4; ++e) { f[i * 8 + 2 * e] = bf_lo(v[i][e]); f[i * 8 + 2 * e + 1] = bf_hi(v[i][e]); s += f[i * 8 + 2 * e] + f[i * 8 + 2 * e + 1]; } }
        const float mu = wave_sum(s) * (1.0f / 1024.0f); float q = 0.f;
#pragma unroll
        for (int e = 0; e < 16; ++e) { f[e] -= mu; q += f[e] * f[e]; }
        const float rstd = 1.0f / sqrtf(wave_sum(q) * (1.0f / 1024.0f) + EPS_);
#pragma unroll
        for (int i = 0; i < 2; ++i) { const int c0 = (lane + 64 * i) * 8; u32x4 w;
            const f32x4 g0 = *(const f32x4*)(lng + c0), g1 = *(const f32x4*)(lng + c0 + 4), b0 = *(const f32x4*)(lnb + c0), b1 = *(const f32x4*)(lnb + c0 + 4);
            w.x = cvt_pk_bf16(f[i * 8 + 0] * rstd * g0[0] + b0[0], f[i * 8 + 1] * rstd * g0[1] + b0[1]); w.y = cvt_pk_bf16(f[i * 8 + 2] * rstd * g0[2] + b0[2], f[i * 8 + 3] * rstd * g0[3] + b0[3]);
            w.z = cvt_pk_bf16(f[i * 8 + 4] * rstd * g1[0] + b1[0], f[i * 8 + 5] * rstd * g1[1] + b1[1]); w.w = cvt_pk_bf16(f[i * 8 + 6] * rstd * g1[2] + b1[2], f[i * 8 + 7] * rstd * g1[3] + b1[3]);
            vp[64 * i] = w; }
    }
}
__device__ __forceinline__ void ynorm_rows(bf16_t* Y, const float* ga, const float* gb, int gw, int NGW, int lane) {
    const int hf = lane >> 5, li = lane & 31; const float* g = hf ? gb : ga;
    for (int r = gw; r < S_; r += 2 * NGW) {
        u32x4* yp0 = (u32x4*)(Y + (size_t)r * 2048 + hf * 1024) + li; u32x4* yp1 = (u32x4*)(Y + (size_t)(r + NGW) * 2048 + hf * 1024) + li;
        u32x4 v[2][4]; float s[2] = {0.f, 0.f};
#pragma unroll
        for (int i = 0; i < 4; ++i) { v[0][i] = yp0[32 * i]; v[1][i] = yp1[32 * i]; }
#pragma unroll
        for (int k = 0; k < 2; ++k) {
#pragma unroll
            for (int i = 0; i < 4; ++i)
#pragma unroll
                for (int e = 0; e < 4; ++e) { const float a = bf_lo(v[k][i][e]), b = bf_hi(v[k][i][e]); s[k] += a * a + b * b; }
            s[k] += shx(s[k], 1); s[k] += shx(s[k], 2); s[k] += shx(s[k], 4); s[k] += shx(s[k], 8); s[k] += shx(s[k], 16);
            s[k] = 1.0f / sqrtf(s[k] * (1.0f / 1024.0f) + EPS_); }
#pragma unroll
        for (int i = 0; i < 4; ++i) { const int c0 = (li + 32 * i) * 8; const f32x4 g0 = *(const f32x4*)(g + c0), g1 = *(const f32x4*)(g + c0 + 4);
#pragma unroll
            for (int k = 0; k < 2; ++k) { const float rstd = s[k]; const u32x4 q = v[k][i]; u32x4 w;
                w.x = cvt_pk_bf16(bf_lo(q.x) * rstd * g0[0], bf_hi(q.x) * rstd * g0[1]); w.y = cvt_pk_bf16(bf_lo(q.y) * rstd * g0[2], bf_hi(q.y) * rstd * g0[3]);
                w.z = cvt_pk_bf16(bf_lo(q.z) * rstd * g1[0], bf_hi(q.z) * rstd * g1[1]); w.w = cvt_pk_bf16(bf_lo(q.w) * rstd * g1[2], bf_hi(q.w) * rstd * g1[3]);
                (k ? yp1 : yp0)[32 * i] = w; } }
    }
}
__device__ __forceinline__ void softmax_rows(const float* SC, bf16_t* P, int gw, int NGW, int lane) {
    const int h = lane >> 4, li = lane & 15;
    for (int r = gw; r < S_; r += NGW) {
        const f32x4* sp = (const f32x4*)(SC + (size_t)r * 1024 + h * 256) + li;
        f32x4 v[4]; float mx = -1e30f;
#pragma unroll
        for (int i = 0; i < 4; ++i) { v[i] = sp[16 * i]; mx = fmaxf(mx, fmaxf(fmaxf(v[i][0], v[i][1]), fmaxf(v[i][2], v[i][3]))); }
        mx = fmaxf(mx, shx(mx, 1)); mx = fmaxf(mx, shx(mx, 2)); mx = fmaxf(mx, shx(mx, 4)); mx = fmaxf(mx, shx(mx, 8));
        float s = 0.f;
#pragma unroll
        for (int i = 0; i < 4; ++i)
#pragma unroll
            for (int e = 0; e < 4; ++e) { v[i][e] = fast_exp(v[i][e] - mx); s += v[i][e]; }
        s += shx(s, 1); s += shx(s, 2); s += shx(s, 4); s += shx(s, 8);
        const float inv = 1.0f / s;
        u32x2* pp = (u32x2*)(P + (size_t)r * 1024 + h * 256) + li;
#pragma unroll
        for (int i = 0; i < 4; ++i) { u32x2 w; w.x = cvt_pk_bf16(v[i][0] * inv, v[i][1] * inv); w.y = cvt_pk_bf16(v[i][2] * inv, v[i][3] * inv); pp[16 * i] = w; }
    }
}

struct TDesc { const float* src; bf16_t* dst; const float* gk; int N, K; };
__device__ __forceinline__ void t_load(const TDesc& d, int lane, f32x4 (&v)[8], f32x4 (&gv)[2]) {
    const int q = lane & 7, kr = lane >> 3;
#pragma unroll
    for (int j = 0; j < 8; ++j) v[j] = *(const f32x4*)(d.src + (size_t)(8 * j + kr) * d.N + 4 * q);
    if (d.gk) { gv[0] = *(const f32x4*)(d.gk + 8 * q); gv[1] = *(const f32x4*)(d.gk + 8 * q + 4); } else { gv[0] = (f32x4){1.f, 1.f, 1.f, 1.f}; gv[1] = gv[0]; }
}
__device__ __forceinline__ void t_store(const TDesc& d, int lane, const f32x4 (&v)[8], const f32x4 (&gv)[2], LAS float* scr) {
    const int q = lane & 7, kr = lane >> 3;
#pragma unroll
    for (int j = 0; j < 8; ++j) { LAS float* w = scr + (8 * j + kr) * 33 + 4 * q; w[0] = v[j][0]; w[1] = v[j][1]; w[2] = v[j][2]; w[3] = v[j][3]; }
    asm volatile("s_waitcnt lgkmcnt(0)" ::: "memory");
    const int c = q;
#pragma unroll
    for (int j = 0; j < 4; ++j) { const int n = (lane >> 3) + 8 * j; const LAS float* s = scr + (8 * c) * 33 + n;
        u32x4 o; o.x = cvt_pk_bf16(s[0 * 33] * gv[0][0], s[1 * 33] * gv[0][1]); o.y = cvt_pk_bf16(s[2 * 33] * gv[0][2], s[3 * 33] * gv[0][3]);
        o.z = cvt_pk_bf16(s[4 * 33] * gv[1][0], s[5 * 33] * gv[1][1]); o.w = cvt_pk_bf16(s[6 * 33] * gv[1][2], s[7 * 33] * gv[1][3]);
        *(u32x4*)(d.dst + (size_t)n * d.K + 8 * c) = o; }
    asm volatile("s_waitcnt lgkmcnt(0)" ::: "memory");
}
template <int MODE> __device__ __forceinline__ void t_desc(TDesc& d, const float* W, int K, int N, bf16_t* WT, const float* gk, int item) {
    const int nblk = N / 32, kb = item / nblk, nb = item % nblk, n0 = 32 * nb, k0 = 64 * kb;
    int drow0 = n0;
    if (MODE == 1) { const int j0 = n0 < FF_ ? n0 : n0 - FF_; drow0 = (j0 >> 7) * 256 + (j0 & 127) + (n0 < FF_ ? 0 : 128); }
    d.src = W + (size_t)k0 * N + n0; d.dst = WT + (size_t)drow0 * K + k0; d.gk = gk ? gk + k0 : nullptr; d.N = N; d.K = K;
}

constexpr int AT_KS = 0, AT_VT = 17408, AT_TB = 35840;
__device__ __forceinline__ void attn_unit(LAS unsigned char* lds, const bf16_t* Z, bf16_t* Y, float* ys, const float* rel_l, const float* gq, const float* gk, int h, int qg, int tid, int wid, int lane) {
    const int fr = lane & 15, fq = lane >> 4;
    const int R0 = qg * 256, cw = 4 * qg + (wid >> 1);
    __syncthreads();
    LAS float* tb = (LAS float*)(lds + AT_TB);
    for (int i = tid; i < 832; i += 512) tb[i] = rel_l[h * 513 + (i < 512 ? i : 512)];
    bf16x8 Qf[2][4];
#pragma unroll
    for (int qt = 0; qt < 2; ++qt)
#pragma unroll
        for (int ks = 0; ks < 4; ++ks) Qf[qt][ks] = *(const bf16x8*)(Z + (size_t)(R0 + 32 * wid + 16 * qt + fr) * NIN_ + h * 128 + 32 * ks + 8 * fq);
    f32x4 O[8][2];
#pragma unroll
    for (int dt = 0; dt < 8; ++dt) { O[dt][0] = (f32x4){0.f, 0.f, 0.f, 0.f}; O[dt][1] = (f32x4){0.f, 0.f, 0.f, 0.f}; }
    float m_run[2] = {-1e30f, -1e30f}, l_run[2] = {0.f, 0.f};
    const int kc_lo = (4 * qg - 8) > 0 ? (4 * qg - 8) : 0, kc_hi = 4 * qg + 3;
    u32x4 kreg[2], vreg[2];
    const char* Zc = (const char*)Z;
    unsigned koff[2], voff_[2];
#pragma unroll
    for (int i = 0; i < 2; ++i) { const int c = tid + 512 * i; koff[i] = (unsigned)(((c >> 4) * NIN_ + 1024 + h * 128 + (c & 15) * 8) * 2); voff_[i] = (unsigned)(((c >> 4) * NIN_ + 2048 + h * 128 + (c & 15) * 8) * 2); }
#define AT_LOAD(kc) do { const char* zk = Zc + (size_t)(kc) * (size_t)(64 * NIN_ * 2); _Pragma("unroll") for (int i = 0; i < 2; ++i) { \
        kreg[i] = *(const u32x4*)(zk + koff[i]); vreg[i] = *(const u32x4*)(zk + voff_[i]); } } while (0)
    AT_LOAD(kc_lo);
    for (int kc = kc_lo; kc <= kc_hi; ++kc) {
        __syncthreads();
#pragma unroll
        for (int i = 0; i < 2; ++i) { const int c = tid + 512 * i;
            *(LAS u32x4*)(lds + AT_KS + (c >> 4) * 272 + (c & 15) * 16) = kreg[i];
            *(LAS u32x4*)(lds + AT_VT + (c >> 4) * 288 + (c & 15) * 16) = vreg[i]; }
        __syncthreads();
        if (kc < kc_hi) AT_LOAD(kc + 1);
        if (kc >= cw - 8 && kc <= cw) {
            f32x4 st[2][4];
#pragma unroll
            for (int nt = 0; nt < 4; ++nt) {
                st[0][nt] = (f32x4){0.f, 0.f, 0.f, 0.f}; st[1][nt] = (f32x4){0.f, 0.f, 0.f, 0.f};
                bf16x8 kf[4];
#pragma unroll
                for (int ks = 0; ks < 4; ++ks) kf[ks] = *(const LAS bf16x8*)(lds + AT_KS + (16 * nt + fr) * 272 + (32 * ks + 8 * fq) * 2);
#pragma unroll
                for (int ks = 0; ks < 4; ++ks) { st[0][nt] = __builtin_amdgcn_mfma_f32_16x16x32_bf16(kf[ks], Qf[0][ks], st[0][nt], 0, 0, 0); st[1][nt] = __builtin_amdgcn_mfma_f32_16x16x32_bf16(kf[ks], Qf[1][ks], st[1][nt], 0, 0, 0); }
                __builtin_amdgcn_sched_barrier(0);
            }
            bf16x8 pf[2][2];
#pragma unroll
            for (int qt = 0; qt < 2; ++qt) {
                const LAS float* tbq = tb + ((cw - kc) * 64 + 32 * (wid & 1) + 16 * qt + fr - 4 * fq + 256 - 63);
                float mx = -1e30f;
#pragma unroll
                for (int nt = 0; nt < 4; ++nt)
#pragma unroll
                    for (int jj = 0; jj < 4; ++jj) { const float s = st[qt][nt][jj] + tbq[63 - 16 * nt - jj]; st[qt][nt][jj] = s; mx = fmaxf(mx, s); }
                mx = fmaxf(mx, shx(mx, 16)); mx = fmaxf(mx, shx(mx, 32));
                const float m_new = fmaxf(m_run[qt], mx), alpha = fast_exp(m_run[qt] - m_new);
                float sum = 0.f;
#pragma unroll
                for (int nt = 0; nt < 4; ++nt)
#pragma unroll
                    for (int jj = 0; jj < 4; ++jj) { const float p = fast_exp(st[qt][nt][jj] - m_new); st[qt][nt][jj] = p; sum += p; }
                sum += shx(sum, 16); sum += shx(sum, 32);
                l_run[qt] = l_run[qt] * alpha + sum; m_run[qt] = m_new;
#pragma unroll
                for (int dt = 0; dt < 8; ++dt) O[dt][qt] = O[dt][qt] * alpha;
#pragma unroll
                for (int k2 = 0; k2 < 2; ++k2) { u32x4 w; w.x = cvt_pk_bf16(st[qt][2 * k2][0], st[qt][2 * k2][1]); w.y = cvt_pk_bf16(st[qt][2 * k2][2], st[qt][2 * k2][3]);
                    w.z = cvt_pk_bf16(st[qt][2 * k2 + 1][0], st[qt][2 * k2 + 1][1]); w.w = cvt_pk_bf16(st[qt][2 * k2 + 1][2], st[qt][2 * k2 + 1][3]); pf[qt][k2] = __builtin_bit_cast(bf16x8, w); }
            }
            __builtin_amdgcn_sched_barrier(0);
            const unsigned vtb = (unsigned)(__SIZE_TYPE__)(lds + AT_VT) + (unsigned)((4 * fq + (fr >> 2)) * 288 + (fr & 3) * 8);
#define AT_TR(dst, OFF) asm volatile("ds_read_b64_tr_b16 %0, %1 offset:%2" : "=&v"(dst) : "v"(vtb), "i"(OFF) : "memory")
#pragma unroll
            for (int dp = 0; dp < 4; ++dp) {
                u32x2 lo[2][2], hi[2][2];
#pragma unroll
                for (int dd = 0; dd < 2; ++dd)
#pragma unroll
                    for (int k2 = 0; k2 < 2; ++k2) { AT_TR(lo[dd][k2], (2 * dp + dd) * 32 + k2 * 32 * 288); AT_TR(hi[dd][k2], (2 * dp + dd) * 32 + k2 * 32 * 288 + 16 * 288); }
                asm volatile("s_waitcnt lgkmcnt(0)" ::: "memory"); __builtin_amdgcn_sched_barrier(0);
#pragma unroll
                for (int dd = 0; dd < 2; ++dd)
#pragma unroll
                    for (int k2 = 0; k2 < 2; ++k2) { const int dt = 2 * dp + dd;
                        u32x4 w; w.x = lo[dd][k2].x; w.y = lo[dd][k2].y; w.z = hi[dd][k2].x; w.w = hi[dd][k2].y; const bf16x8 vf = __builtin_bit_cast(bf16x8, w);
                        O[dt][0] = __builtin_amdgcn_mfma_f32_16x16x32_bf16(vf, pf[0][k2], O[dt][0], 0, 0, 0); O[dt][1] = __builtin_amdgcn_mfma_f32_16x16x32_bf16(vf, pf[1][k2], O[dt][1], 0, 0, 0); }
                __builtin_amdgcn_sched_barrier(0);
            }
#undef AT_TR
        }
    }
#undef AT_LOAD
#pragma unroll
    for (int qt = 0; qt < 2; ++qt) { const float inv = 1.0f / l_run[qt]; const int row = R0 + 32 * wid + 16 * qt + fr; bf16_t* yr = Y + (size_t)row * 2048 + h * 128 + 4 * fq; float sq = 0.f;
#pragma unroll
        for (int dt = 0; dt < 8; ++dt) { const f32x4 o = O[dt][qt] * inv; sq += (o[0] * o[0] + o[1] * o[1]) + (o[2] * o[2] + o[3] * o[3]); u32x2 w; w.x = cvt_pk_bf16(o[0], o[1]); w.y = cvt_pk_bf16(o[2], o[3]); *(u32x2*)(yr + 16 * dt) = w; }
        sq += shx(sq, 16); sq += shx(sq, 32); ys[(size_t)row * 16 + h] = sq; }
}

constexpr int GM_RS = 528;
__device__ __forceinline__ void gmlp2_unit(LAS unsigned char* lds, const bf16_t* Z, bf16_t* Y, float* ys, const bf16_t* Wsm_l, const float* bs_l, const float* vs, const float* lng, const float* lnb, int nb, int gp, int tid, int wid, int lane) {
    const int fr = lane & 15, fq = lane >> 4;
    __syncthreads();
    {   const int t = tid & 127;
        const f32x4* sp = (const f32x4*)(vs + (size_t)(nb * 128 + t) * 32);
        float s1 = 0.f, s2 = 0.f;
#pragma unroll
        for (int i = 0; i < 8; ++i) { const f32x4 q = sp[i]; s1 += q[0] + q[2]; s2 += q[1] + q[3]; }
        const float mu = s1 * (1.0f / 1024.0f), rstd = 1.0f / sqrtf(fmaxf(s2 * (1.0f / 1024.0f) - mu * mu, 0.f) + EPS_);
        const bf16_t* zr = Z + (size_t)(nb * 128 + t) * NIN_ + 4096 + gp * 256;
        u32x4 v[8];
#pragma unroll
        for (int i = 0; i < 8; ++i) v[i] = *(const u32x4*)(zr + ((tid >> 7) + 4 * i) * 8);
#pragma unroll
        for (int i = 0; i < 8; ++i) { const int dch = (tid >> 7) + 4 * i;
            const float* gpn = lng + gp * 256 + dch * 8; const float* bpn = lnb + gp * 256 + dch * 8;
            const f32x4 g0 = *(const f32x4*)gpn, g1 = *(const f32x4*)(gpn + 4), b0 = *(const f32x4*)bpn, b1 = *(const f32x4*)(bpn + 4);
            u32x4 w;
            w.x = cvt_pk_bf16((bf_lo(v[i].x) - mu) * rstd * g0[0] + b0[0], (bf_hi(v[i].x) - mu) * rstd * g0[1] + b0[1]); w.y = cvt_pk_bf16((bf_lo(v[i].y) - mu) * rstd * g0[2] + b0[2], (bf_hi(v[i].y) - mu) * rstd * g0[3] + b0[3]);
            w.z = cvt_pk_bf16((bf_lo(v[i].z) - mu) * rstd * g1[0] + b1[0], (bf_hi(v[i].z) - mu) * rstd * g1[1] + b1[1]); w.w = cvt_pk_bf16((bf_lo(v[i].w) - mu) * rstd * g1[2] + b1[2], (bf_hi(v[i].w) - mu) * rstd * g1[3] + b1[3]);
            *(LAS u32x4*)(lds + t * GM_RS + dch * 16) = w; } }
    const int row = nb * 128 + 16 * wid + fr;
    const unsigned gtb = (unsigned)(__SIZE_TYPE__)lds + (unsigned)((8 * fq + (fr >> 2)) * GM_RS + (fr & 3) * 8);
    __syncthreads();
#pragma unroll
    for (int g2 = 0; g2 < 2; ++g2) {
        const int g = 2 * gp + g2;
        bf16x8 wsf[4];
#pragma unroll
        for (int ks = 0; ks < 4; ++ks) wsf[ks] = *(const bf16x8*)(Wsm_l + (size_t)(g * 128 + 16 * wid + fr) * 128 + 32 * ks + 8 * fq);
        const float bs = bs_l[g * 128 + 16 * wid + fr]; float ysq = 0.f;
        u32x2 uu[8];
#pragma unroll
        for (int ct = 0; ct < 8; ++ct) uu[ct] = *(const u32x2*)(Z + (size_t)row * NIN_ + 3072 + g * 128 + 16 * ct + 4 * fq);
#pragma unroll
        for (int ct = 0; ct < 8; ++ct) {
            f32x4 acc = (f32x4){0.f, 0.f, 0.f, 0.f};
            {   u32x2 lo[4], hi[4];
#pragma unroll
                for (int ks = 0; ks < 4; ++ks) {
                    asm volatile("ds_read_b64_tr_b16 %0, %1 offset:%2" : "=&v"(lo[ks]) : "v"(gtb), "i"(ks * 32 * GM_RS + g2 * 256 + ct * 32) : "memory");
                    asm volatile("ds_read_b64_tr_b16 %0, %1 offset:%2" : "=&v"(hi[ks]) : "v"(gtb), "i"(ks * 32 * GM_RS + 4 * GM_RS + g2 * 256 + ct * 32) : "memory"); }
                asm volatile("s_waitcnt lgkmcnt(0)" ::: "memory"); __builtin_amdgcn_sched_barrier(0);
#pragma unroll
                for (int ks = 0; ks < 4; ++ks) { u32x4 w; w.x = lo[ks].x; w.y = lo[ks].y; w.z = hi[ks].x; w.w = hi[ks].y; acc = __builtin_amdgcn_mfma_f32_16x16x32_bf16(__builtin_bit_cast(bf16x8, w), wsf[ks], acc, 0, 0, 0); }
            }
            const float y0 = bf_lo(uu[ct].x) * (acc[0] + bs), y1 = bf_hi(uu[ct].x) * (acc[1] + bs), y2 = bf_lo(uu[ct].y) * (acc[2] + bs), y3 = bf_hi(uu[ct].y) * (acc[3] + bs);
            ysq += (y0 * y0 + y1 * y1) + (y2 * y2 + y3 * y3);
            u32x2 w; w.x = cvt_pk_bf16(y0, y1); w.y = cvt_pk_bf16(y2, y3);
            *(u32x2*)(Y + (size_t)row * 2048 + 1024 + g * 128 + 16 * ct + 4 * fq) = w;
        }
        ysq += shx(ysq, 16); ysq += shx(ysq, 32); ys[(size_t)row * 16 + 8 + g] = ysq;
    }
}

#define PROBE_DUP 0
#define NREP(k) ((PROBE_DUP == (k)) ? 2 : 1)
__global__ void __launch_bounds__(NWAVES * 64, 2) mega_fwd(Args a) {
    extern __shared__ __attribute__((aligned(16))) unsigned char lds_raw[];
    LAS unsigned char* lds = (LAS unsigned char*)lds_raw;
    cg::grid_group grid = cg::this_grid();
    int tid = threadIdx.x, lane = tid & 63, wid = __builtin_amdgcn_readfirstlane(tid >> 6);
    const int G = (int)gridDim.x, NGW = G * NWAVES; int gw = (int)blockIdx.x * NWAVES + wid;
#define PHASE_BEGIN() do { tid = threadIdx.x; asm volatile("" : "+v"(tid)); lane = tid & 63; wid = __builtin_amdgcn_readfirstlane(tid >> 6); gw = (int)blockIdx.x * NWAVES + wid; } while (0)
    unsigned char* const ws = a.ws;
#define XN ((bf16_t*)(ws + WS_XN))
#define HB ((bf16_t*)(ws + WS_H))
#define ZB ((bf16_t*)(ws + WS_H))
#define YB ((bf16_t*)(ws + WS_Y))
#define QM ((bf16_t*)(ws + WS_Y))
#define SC ((float*)(ws + WS_H))
#define PB ((bf16_t*)(ws + WS_H + H_OFF_P))
#define WKV ((bf16_t*)(ws + WS_WKV))
#define WSM ((bf16_t*)(ws + WS_WSM))
#define AMEM ((bf16_t*)(ws + WS_AMEM))
#define KVALL ((bf16_t*)(ws + WS_KVALL))
#define KN ((bf16_t*)(ws + WS_KN))
#define X (a.out)
#define SS ((float*)(ws + WS_SS))
#define QS ((float*)(ws + WS_QS))
#define VS ((float*)(ws + WS_VS))
#define YS ((float*)(ws + WS_YS))
#define YS ((float*)(ws + WS_YS))

    volatile LAS unsigned* bst = (volatile LAS unsigned*)(lds + 131072 + 12288);
    if (tid == 0) { bst[0] = 0u; bst[1] = 0u; }

    {
        LAS float* scr = (LAS float*)(lds + wid * 16384);
        constexpr int I_1 = (D_ / 64) * (2 * FF_ / 32), I_2 = (FF_ / 64) * (D_ / 32), I_IN = (D_ / 64) * (NIN_ / 32), I_DD = (D_ / 64) * (D_ / 32), I_KV = (D_ / 64) * (2 * D_ / 32);
        constexpr int PER_L = 2 * I_1 + 2 * I_2 + I_IN + 3 * I_DD + I_KV;
#define T_DECODE(d, it_) do { const int l = (it_) / PER_L; int r = (it_) % PER_L; unsigned char* wl = ws + (size_t)l * LO_END; \
            if (r < I_1) { t_desc<1>(d, a.in[I_W_FFN1_IN] + (size_t)l * D_ * 2 * FF_, D_, 2 * FF_, (bf16_t*)(wl + LO_W1A), a.in[I_G_FFN1] + l * D_, r); break; } r -= I_1; \
            if (r < I_1) { t_desc<1>(d, a.in[I_W_FFN2_IN] + (size_t)l * D_ * 2 * FF_, D_, 2 * FF_, (bf16_t*)(wl + LO_W1B), a.in[I_G_FFN2] + l * D_, r); break; } r -= I_1; \
            if (r < I_2) { t_desc<0>(d, a.in[I_W_FFN1_OUT] + (size_t)l * FF_ * D_, FF_, D_, (bf16_t*)(wl + LO_W2A), nullptr, r); break; } r -= I_2; \
            if (r < I_2) { t_desc<0>(d, a.in[I_W_FFN2_OUT] + (size_t)l * FF_ * D_, FF_, D_, (bf16_t*)(wl + LO_W2B), nullptr, r); break; } r -= I_2; \
            if (r < I_IN) { t_desc<0>(d, a.in[I_W_IN] + (size_t)l * D_ * NIN_, D_, NIN_, (bf16_t*)(wl + LO_WIN), a.in[I_G_MIX] + l * D_, r); break; } r -= I_IN; \
            if (r < I_DD) { const int kb_ = r / (D_ / 32); t_desc<0>(d, a.in[I_W_OUT] + (size_t)l * D_ * D_, D_, D_, (bf16_t*)(wl + LO_WOUT), (kb_ < 16 ? a.in[I_G_OUT_A] + l * 1024 : a.in[I_G_OUT_B] + l * 1024 - 1024), r); break; } r -= I_DD; \
            if (r < I_DD) { t_desc<0>(d, a.in[I_W_MEM_Q] + (size_t)l * D_ * D_, D_, D_, (bf16_t*)(wl + LO_WQ), a.in[I_G_MEM_Q] + l * D_, r); break; } r -= I_DD; \
            if (r < I_DD) { t_desc<0>(d, a.in[I_W_MEM_O] + (size_t)l * D_ * D_, D_, D_, (bf16_t*)(wl + LO_WO), nullptr, r); break; } r -= I_DD; \
            t_desc<0>(d, a.in[I_W_MEM_KV] + (size_t)l * D_ * 2 * D_, D_, 2 * D_, WKV + (size_t)l * 2 * D_ * D_, nullptr, r); } while (0)
        for (int rep = 0; rep < NREP(1); ++rep) {
            TDesc dc, dn; f32x4 va[8], vb[8], ga[2], gb[2];
            int it = gw;
            if (it < 2 * PER_L) { T_DECODE(dc, it); t_load(dc, lane, va, ga); }
            for (; it < 2 * PER_L; it += NGW) {
                const bool more = it + NGW < 2 * PER_L;
                if (more) { T_DECODE(dn, it + NGW); t_load(dn, lane, vb, gb); }
                t_store(dc, lane, va, ga, scr);
                if (more) { dc = dn;
#pragma unroll
                    for (int j = 0; j < 8; ++j) va[j] = vb[j];
                    ga[0] = gb[0]; ga[1] = gb[1]; }
            }
        }
#undef T_DECODE
        for (int i = (int)blockIdx.x * 512 + tid; i < 2 * 8 * 128 * 128 / 2; i += G * 512) {
            const int e = 2 * i, t = e & 127, s = (e >> 7) & 127; const f32x2 w = *(const f32x2*)(a.in[I_W_S] + e);
            const bool keep = (s >> 6) >= (t >> 6);
            ((unsigned*)WSM)[i] = keep ? cvt_pk_bf16(w.x, w.y) : 0u;
        }
        if (gw < 2) for (int d = lane; d < 128; d += 64) ((float*)(ws + WS_GQK))[gw * 128 + d] = a.in[I_G_Q_A][gw * 128 + d] * a.in[I_G_K_A][gw * 128 + d] * 0.08838834764831845f;
        for (int l = 0; l < 2; ++l) rms_rows_2048(a.in[I_MEM], a.in[I_G_MEM_KV] + l * D_, AMEM + (size_t)l * 256 * D_, 256, gw, NGW, lane);
        rows_bf16_ss(a.in[I_X], XN, SS, S_, gw, NGW, lane);
    }
    if (a.ws == nullptr) grid.sync();
    const XcdBarrier xbar = xcd_barrier_post((unsigned*)(ws + WS_BAR), bst);
#define GRID_BAR() xcd_barrier(xbar)
    GRID_BAR(); PHASE_BEGIN();
    if (PROBE_DUP == 6) { for (int i = 0; i < 10; ++i) GRID_BAR(); }

#pragma unroll
    for (int l = 0; l < 2; ++l) {
        unsigned char* wl = ws + (size_t)l * LO_END;
        const float* xin = (l == 0) ? a.in[I_X] : X;
        {   pg8::Gemm g{XN, (const bf16_t*)(wl + LO_W1A), D_, D_, D_, S_ / 256, 2 * FF_ / 256, 256u * D_ * 2u, 0, 0, 256u * D_ * 2u, 0};
            pg8::Epi<1, true> E{HB, FF_, nullptr, 1.f, 0, SS, nullptr, nullptr, nullptr, 0, 0, nullptr}; for (int rep = 0; rep < (l == 1 ? NREP(2) : 1); ++rep) pg8::gemm_phase(lds, g, E); }
        if (l == 0) {
            pg8::Gemm g{AMEM, WKV, D_, D_, D_, 2, 32, 256u * D_ * 2u, 0, 0, 256u * D_ * 2u, 64};
            pg8::Epi<0> E{KVALL, 8192, nullptr, 1.f, 1 << 30, nullptr, nullptr, nullptr, nullptr, 0, 0, nullptr}; pg8::gemm_phase(lds, g, E); }
        GRID_BAR(); PHASE_BEGIN();
        {   pg8::Gemm g{HB, (const bf16_t*)(wl + LO_W2A), FF_, FF_, FF_, S_ / 256, D_ / 256, 256u * FF_ * 2u, 0, 0, 256u * FF_ * 2u, 0};
            if (PROBE_DUP == 3 && l == 1) { pg8::Epi<2, true> E2{(float*)(ws + WS_END), D_, xin, 0.5f, 0, nullptr, YB, (float*)(ws + WS_END + (size_t)S_ * D_ * 4), nullptr, 0, 0, nullptr}; pg8::gemm_phase(lds, g, E2); }
            pg8::Epi<2, true> E{X, D_, xin, 0.5f, 0, nullptr, XN, SS, nullptr, 0, 0, nullptr}; pg8::gemm_phase(lds, g, E); }
        if (l == 0) {
            PHASE_BEGIN();
            for (int ll = 0; ll < 2; ++ll) headnorm512_rows(KVALL + (size_t)ll * 256 * 8192 + ll * 4096, 8192, KN + (size_t)ll * 256 * D_, D_, a.in[I_G_K_MEM] + ll * 512, a.in[I_G_Q_MEM] + ll * 512, 0.04419417382415922f, 256, gw, NGW, lane);
            for (int ll = 0; ll < 2; ++ll) {
                pg8::Gemm g{(const bf16_t*)(ws + (size_t)ll * LO_END + LO_WO), KVALL + (size_t)ll * 256 * 8192 + ll * 4096 + 2048, D_, 8192, 512, 8, 4, 256u * D_ * 2u, 512u * 2u, 0, 512u * 2u,ll ? 224 : 0};
                pg8::Epi<0> E{(bf16_t*)(ws + (size_t)ll * LO_END + LO_VW), 1024, nullptr, 1.f, 1 << 30, nullptr, nullptr, nullptr, nullptr, 0, 0, nullptr}; pg8::gemm_phase(lds, g, E); }
        }
        GRID_BAR(); PHASE_BEGIN();
        {   pg8::Gemm g{XN, (const bf16_t*)(wl + LO_WIN), D_, D_, D_, S_ / 256, NIN_ / 256, 256u * D_ * 2u, 0, 0, 256u * D_ * 2u, 0};
            pg8::Epi<0, true, true, true> E{ZB, NIN_, (const float*)(ws + WS_GQK) + l * 128, 1.f, 12, SS, nullptr, nullptr, VS, 16, 16, lds + 131072}; for (int rep = 0; rep < (l == 1 ? NREP(4) : 1); ++rep) pg8::gemm_phase(lds, g, E); }
        GRID_BAR(); PHASE_BEGIN();
#ifndef NO_ATTN
        for (int rep = 0; rep < (l == 1 ? NREP(5) : 1); ++rep)
        for (int it = (int)blockIdx.x; it < 512 + 512; it += G) {
            if (it < 512) attn_unit(lds, ZB, YB, YS, a.in[I_REL] + (size_t)l * 8 * 513, a.in[I_G_Q_A] + l * 128, a.in[I_G_K_A] + l * 128, it & 7, it >> 3, tid, wid, lane);
            else { const int j = it - 512; gmlp2_unit(lds, ZB, YB, YS, WSM + (size_t)l * 8 * 128 * 128, a.in[I_B_S] + l * 1024, VS, a.in[I_LN_G] + l * 1024, a.in[I_LN_B] + l * 1024, j >> 2, j & 3, tid, wid, lane); }
        }
#endif
        GRID_BAR(); PHASE_BEGIN();
        {   pg8::Gemm g{YB, (const bf16_t*)(wl + LO_WOUT), D_, D_, D_, S_ / 256, D_ / 256, 256u * D_ * 2u, 0, 0, 256u * D_ * 2u, 0};
            pg8::Epi<5> E{X, D_, X, 1.0f, 0, YS, XN, SS, nullptr, 0, 0, nullptr}; pg8::gemm_phase(lds, g, E); }
        GRID_BAR(); PHASE_BEGIN();
        {   pg8::Gemm g{XN, (const bf16_t*)(wl + LO_WQ), D_, D_, D_, S_ / 256, D_ / 256, 256u * D_ * 2u, 0, 0, 256u * D_ * 2u, 0};
            pg8::Epi<0, true, true> E{QM, D_, nullptr, 1.f, 1 << 30, SS, nullptr, nullptr, QS, 32, 0, nullptr}; pg8::gemm_phase(lds, g, E); }
        GRID_BAR(); PHASE_BEGIN();
        {   pg8::Gemm g{QM, KN + (size_t)l * 256 * D_, D_, D_, 512, S_ / 256, 4, 256u * D_ * 2u, 512u * 2u, 0, 512u * 2u, 0};
            pg8::Epi<4> E{PB, 1024, nullptr, 1.f, 0, QS, nullptr, nullptr, nullptr, 0, 0, lds + 131072}; pg8::gemm_phase(lds, g, E); }
        GRID_BAR(); PHASE_BEGIN();
        {   pg8::Gemm g{PB, (const bf16_t*)(wl + LO_VW), 1024, 1024, 1024, S_ / 256, D_ / 256, 256u * 1024u * 2u, 0, 0, 256u * 1024u * 2u, 0};
            pg8::Epi<2, true> E{X, D_, X, 1.0f, 0, nullptr, XN, SS, nullptr, 0, 0, nullptr}; pg8::gemm_phase(lds, g, E); }
        GRID_BAR(); PHASE_BEGIN();
        {   pg8::Gemm g{XN, (const bf16_t*)(wl + LO_W1B), D_, D_, D_, S_ / 256, 2 * FF_ / 256, 256u * D_ * 2u, 0, 0, 256u * D_ * 2u, 0};
            pg8::Epi<1, true> E{HB, FF_, nullptr, 1.f, 0, SS, nullptr, nullptr, nullptr, 0, 0, nullptr}; pg8::gemm_phase(lds, g, E); }
        GRID_BAR(); PHASE_BEGIN();
        {   pg8::Gemm g{HB, (const bf16_t*)(wl + LO_W2B), FF_, FF_, FF_, S_ / 256, D_ / 256, 256u * FF_ * 2u, 0, 0, 256u * FF_ * 2u, 0};
            if (l == 0) { pg8::Epi<2, true> E{X, D_, X, 0.5f, 0, nullptr, XN, SS, nullptr, 0, 0, nullptr}; pg8::gemm_phase(lds, g, E); }
            else { pg8::Epi<2, false> E{X, D_, X, 0.5f, 0, nullptr, nullptr, nullptr, nullptr, 0, 0, nullptr}; pg8::gemm_phase(lds, g, E); } }
        if (l == 0) { GRID_BAR(); PHASE_BEGIN(); }
    }
}

extern "C" void kernel_launch(void* const* d_in, const int* in_sizes, int n_in, void* d_out, int out_size, void* d_ws, size_t ws_size, hipStream_t stream) {
    static int grid = 0;
    if (grid == 0) {
        if (n_in != 27 || out_size != S_ * D_ || ws_size < WS_END + (size_t)S_ * D_ * 4 + (size_t)S_ * 128) { fprintf(stderr, "kernel_launch: unexpected shapes (n_in %d out %d ws %zu need %zu)\n", n_in, out_size, ws_size, (size_t)WS_END); grid = -1; return; }
        int dev = 0, cus = 0, per_cu = 0;
        hipGetDevice(&dev);
        hipDeviceGetAttribute(&cus, hipDeviceAttributeMultiprocessorCount, dev);
        if (hipFuncSetAttribute((const void*)mega_fwd, hipFuncAttributeMaxDynamicSharedMemorySize, LDS_BYTES) != hipSuccess) { fprintf(stderr, "kernel_launch: hipFuncSetAttribute failed\n"); grid = -1; return; }
        if (hipOccupancyMaxActiveBlocksPerMultiprocessor(&per_cu, (const void*)mega_fwd, NWAVES * 64, LDS_BYTES) != hipSuccess || per_cu < 1) { fprintf(stderr, "kernel_launch: occupancy query gave %d\n", per_cu); per_cu = 1; }
        (void)hipGetLastError();
        grid = cus * per_cu;
    }
    if (grid < 0) return;
    Args a{};
    for (int i = 0; i < 27; ++i) a.in[i] = (const float*)d_in[i];
    a.out = (float*)d_out; a.ws = (unsigned char*)d_ws;
    void* args[] = {&a};
    if (hipMemsetAsync((unsigned char*)d_ws + WS_BAR, 0, 16384, stream) != hipSuccess) { fprintf(stderr, "kernel_launch: hipMemsetAsync of the barrier words failed\n"); return; }
    hipError_t e = hipLaunchCooperativeKernel((const void*)mega_fwd, dim3(grid), dim3(NWAVES * 64), args, LDS_BYTES, stream);
    if (e != hipSuccess) fprintf(stderr, "kernel_launch: cooperative launch failed: %s (grid %d)\n", hipGetErrorString(e), grid);
}
```

```cpp
#include <hip/hip_runtime.h>
#include <hip/hip_cooperative_groups.h>
#include <cstdio>
#include <cstdint>
namespace cg = cooperative_groups;

#define LAS __attribute__((address_space(3)))
typedef unsigned short bf16_t;
typedef short bf16x8 __attribute__((ext_vector_type(8)));
typedef float f32x4 __attribute__((ext_vector_type(4)));
typedef float f32x2 __attribute__((ext_vector_type(2)));
typedef unsigned u32x4 __attribute__((ext_vector_type(4)));
typedef unsigned u32x2 __attribute__((ext_vector_type(2)));

constexpr int S_ = 16384, D_ = 2048, FF_ = 5504, NIN_ = 5120, NMEM_ = 256;
constexpr float EPS_ = 1e-6f;
constexpr int NWAVES = 8;
constexpr int LDS_BYTES = 147456;

constexpr size_t SZ_W1 = (size_t)2 * FF_ * D_ * 2, SZ_W2 = (size_t)D_ * FF_ * 2, SZ_WIN = (size_t)NIN_ * D_ * 2, SZ_DD = (size_t)D_ * D_ * 2, SZ_WKV = (size_t)2 * D_ * D_ * 2;
constexpr size_t LO_W1A = 0, LO_W2A = LO_W1A + SZ_W1, LO_WIN = LO_W2A + SZ_W2, LO_WOUT = LO_WIN + SZ_WIN, LO_WQ = LO_WOUT + SZ_DD, LO_WO = LO_WQ + SZ_DD,
                 LO_W1B = LO_WO + SZ_DD, LO_W2B = LO_W1B + SZ_W1, LO_VW = LO_W2B + SZ_W2, LO_END = LO_VW + (size_t)D_ * 1024 * 2;
constexpr size_t WS_WKV = 2 * LO_END, WS_WSM = WS_WKV + 2 * SZ_WKV, WS_AMEM = WS_WSM + (size_t)2 * 8 * 128 * 128 * 2, WS_KVALL = WS_AMEM + (size_t)512 * 2048 * 2,
                 WS_KN = WS_KVALL + (size_t)512 * 8192 * 2, WS_XN = WS_KN + (size_t)2 * 256 * 2048 * 2, WS_H = WS_XN + (size_t)S_ * D_ * 2, WS_Y = WS_H + (size_t)S_ * FF_ * 2,
                 WS_SS = WS_Y + (size_t)S_ * D_ * 2, WS_BAR = WS_SS + (size_t)S_ * 32 * 4, WS_QS = WS_BAR + 16384, WS_VS = WS_QS + (size_t)S_ * 32 * 8, WS_YS = WS_VS + (size_t)S_ * 16 * 8, WS_GQK = WS_YS + (size_t)S_ * 16 * 4, WS_END = WS_GQK + 1024;
constexpr size_t H_OFF_P = (size_t)80 << 20;

__device__ __forceinline__ unsigned cvt_pk_bf16(float lo, float hi) { unsigned r; asm("v_cvt_pk_bf16_f32 %0, %1, %2" : "=v"(r) : "v"(lo), "v"(hi)); return r; }
__device__ __forceinline__ float bf_lo(unsigned u) { return __uint_as_float(u << 16); }
__device__ __forceinline__ float bf_hi(unsigned u) { return __uint_as_float(u & 0xffff0000u); }
__device__ __forceinline__ float fast_exp(float x) { return __builtin_amdgcn_exp2f(x * 1.44269504089f); }
__device__ __forceinline__ float silu_f(float a) { return a * __builtin_amdgcn_rcpf(1.0f + fast_exp(-a)); }
__device__ __forceinline__ float gelu_f(float x) { const float y = 1.5957691216f * (x + 0.044715f * x * x * x); return x * __builtin_amdgcn_rcpf(1.0f + fast_exp(-y)); }
__device__ __forceinline__ float shx(float v, int m) {
    int l_ = (int)__builtin_amdgcn_mbcnt_hi(~0u, __builtin_amdgcn_mbcnt_lo(~0u, 0u)); asm volatile("" : "+v"(l_)); const int idx = (l_ ^ m) << 2;
    return __builtin_bit_cast(float, __builtin_amdgcn_ds_bpermute(idx, __builtin_bit_cast(int, v)));
}
__device__ __forceinline__ float wave_sum(float v) {
#pragma unroll
    for (int o = 1; o < 64; o <<= 1) v += shx(v, o);
    return v;
}

namespace pg8 {
constexpr int BM = 256, BK = 64, HALF = 128, HTB = HALF * BK * 2, STAGE_BYTES = 8 * HTB, NXCD = 8, WGM = 8;
__host__ __device__ __forceinline__ int lds_byte(int r, int c) { const int st = (r >> 4) * 2 + (c >> 5), rr = r & 15, cc = c & 31, ob = rr * 64 + cc * 2; return st * 1024 + (ob ^ (((ob >> 9) & 1) << 5)); }
__host__ __device__ __forceinline__ void stage_rc(int b, int& R, int& C) { const int st = b / 1024, sb = b % 1024, swz = sb ^ (((sb >> 9) & 1) << 5); R = (st >> 1) * 16 + swz / 64; C = (st & 1) * 32 + (swz % 64) / 2; }
__host__ __device__ __forceinline__ int perm32(int rho) { const int n = rho >> 4, i = rho & 15; return 8 * (i >> 2) + 4 * n + (i & 3); }

struct Unit { int pm, pn; };
struct Gemm { const bf16_t* A; const bf16_t* Bt; int lda, ldb, K, nM, nN; unsigned a_pm, a_pn, b_pm, b_pn; int bx_off; int vG; };

struct StaticOrder {
    int nM, nN, nwg, G, c;
    __device__ void init(int nM_, int nN_, int G_, int c_) { nM = nM_; nN = nN_; nwg = nM * nN; G = G_; c = c_; }
    __device__ bool next(int i, Unit& u) const {
        const int L = i * G + c; if (L >= nwg) return false;
        int wgid = L; { const int q = nwg / NXCD, r = nwg % NXCD, xcd = wgid % NXCD, off = wgid / NXCD; wgid = (xcd < r ? xcd * (q + 1) : r * (q + 1) + (xcd - r) * q) + off; }
        const int nig = WGM * nN, gid = wgid / nig, fm = gid * WGM, gsz = (nM - fm) < WGM ? (nM - fm) : WGM;
        u.pm = fm + ((wgid % nig) % gsz); u.pn = (wgid % nig) / gsz; return true;
    }
};

template <int MODE, bool FLAG = false, bool STATS = false, bool HN = false> struct Epi {
    static constexpr bool MIDK = (MODE == 5);
    void* out; int ldc; const float* base; float scale; int gelu_pn; const float* ss; bf16_t* xb; float* sso; float* st; int st_n, st_pn0; LAS unsigned char* xch;
    __device__ __forceinline__ void row_vars(const Unit& u, int ai, int wr, int fr, int fq, float (&va)[4], float (&vb)[4]) const {
        const int row0 = u.pm * BM + wr * 64 + fr + ai * HALF; f32x4 q[4];
#pragma unroll
        for (int m = 0; m < 4; ++m) q[m] = *(const f32x4*)(ss + (size_t)(row0 + m * 16) * 16 + 4 * fq);
#pragma unroll
        for (int m = 0; m < 4; ++m) { float t = (q[m][0] + q[m][1]) + (q[m][2] + q[m][3]); t += shx(t, 16); const float o = shx(t, 32);
            va[m] = (fq < 2 ? t : o) * (1.0f / 1024.0f) + EPS_; vb[m] = (fq < 2 ? o : t) * (1.0f / 1024.0f) + EPS_; }
    }
    __device__ __forceinline__ void midk_factors(float (&fm)[2][4], const Unit& u, int wr, int fr, int fq) const {
#pragma unroll
        for (int ai = 0; ai < 2; ++ai) {
            float va[4], vb[4]; row_vars(u, ai, wr, fr, fq, va, vb);
#pragma unroll
            for (int m = 0; m < 4; ++m) fm[ai][m] = sqrtf(vb[m] / va[m]);
        }
    }
    __device__ __forceinline__ void operator()(const f32x4 (&acc)[2][2][4][2], const Unit& u, int wr, int wc, int fr, int fq) const {
        const int row0 = u.pm * BM + wr * 64 + fr;
        float rs[2][4];
        if constexpr (MODE == 0 || MODE == 1) {
#pragma unroll
            for (int ai = 0; ai < 2; ++ai)
#pragma unroll
                for (int m = 0; m < 4; ++m) rs[ai][m] = 1.0f;
            if constexpr (FLAG) {
                f32x4 x0[2][4], x1[2][4];
#pragma unroll
                for (int ai = 0; ai < 2; ++ai)
#pragma unroll
                    for (int m = 0; m < 4; ++m) { const float* p = ss + (size_t)(row0 + ai * HALF + m * 16) * 32 + fq * 8; x0[ai][m] = *(const f32x4*)p; x1[ai][m] = *(const f32x4*)(p + 4); }
#pragma unroll
                for (int ai = 0; ai < 2; ++ai)
#pragma unroll
                    for (int m = 0; m < 4; ++m) {
                        float t = ((x0[ai][m][0] + x0[ai][m][1]) + (x0[ai][m][2] + x0[ai][m][3])) + ((x1[ai][m][0] + x1[ai][m][1]) + (x1[ai][m][2] + x1[ai][m][3])); t += shx(t, 16); t += shx(t, 32);
                        rs[ai][m] = 1.0f / sqrtf(t * (1.0f / 2048.0f) + EPS_); }
            }
        }
        if constexpr (MODE == 1) {
            bf16_t* O = (bf16_t*)out; const int col0 = u.pn * HALF + wc * 32 + 8 * fq;
#pragma unroll
            for (int ai = 0; ai < 2; ++ai)
#pragma unroll
                for (int m = 0; m < 4; ++m) {
                    const float r = rs[ai][m];
                    const f32x4 a0 = acc[ai][0][m][0] * r, a1 = acc[ai][0][m][1] * r, b0 = acc[ai][1][m][0] * r, b1 = acc[ai][1][m][1] * r;
                    u32x4 w;
                    w.x = cvt_pk_bf16(silu_f(a0[0]) * b0[0], silu_f(a0[1]) * b0[1]); w.y = cvt_pk_bf16(silu_f(a0[2]) * b0[2], silu_f(a0[3]) * b0[3]);
                    w.z = cvt_pk_bf16(silu_f(a1[0]) * b1[0], silu_f(a1[1]) * b1[1]); w.w = cvt_pk_bf16(silu_f(a1[2]) * b1[2], silu_f(a1[3]) * b1[3]);
                    *(u32x4*)(O + (size_t)(row0 + ai * HALF + m * 16) * ldc + col0) = w;
                }
        } else if constexpr (MODE == 2 || MODE == 5) {
            constexpr bool XBF = FLAG || MODE == 5;
            const int col0 = u.pn * BM + wc * 32 + 8 * fq;
#pragma unroll
            for (int ai = 0; ai < 2; ++ai) {
                float rb5[4] = {1.f, 1.f, 1.f, 1.f};
                if constexpr (MODE == 5) { float va[4], vb[4]; row_vars(u, ai, wr, fr, fq, va, vb);
#pragma unroll
                    for (int m = 0; m < 4; ++m) rb5[m] = 1.0f / sqrtf(vb[m]); }
                f32x4 bs[4][2][2];
#pragma unroll
                for (int m = 0; m < 4; ++m)
#pragma unroll
                    for (int bj = 0; bj < 2; ++bj) { const float* bp = base + (size_t)(row0 + ai * HALF + m * 16) * ldc + col0 + bj * HALF; bs[m][bj][0] = *(const f32x4*)bp; bs[m][bj][1] = *(const f32x4*)(bp + 4); }
#pragma unroll
                for (int m = 0; m < 4; ++m) {
                    const size_t roff = (size_t)(row0 + ai * HALF + m * 16) * ldc + col0;
                    float sq = 0.f;
#pragma unroll
                    for (int bj = 0; bj < 2; ++bj) {
                        const float sc = (MODE == 5) ? rb5[m] : scale;
                        const f32x4 x0 = bs[m][bj][0] + acc[ai][bj][m][0] * sc, x1 = bs[m][bj][1] + acc[ai][bj][m][1] * sc;
                        *(f32x4*)((float*)out + roff + bj * HALF) = x0; *(f32x4*)((float*)out + roff + bj * HALF + 4) = x1;
                        if constexpr (XBF) {
                            u32x4 w; w.x = cvt_pk_bf16(x0[0], x0[1]); w.y = cvt_pk_bf16(x0[2], x0[3]); w.z = cvt_pk_bf16(x1[0], x1[1]); w.w = cvt_pk_bf16(x1[2], x1[3]);
                            *(u32x4*)(xb + roff + bj * HALF) = w;
                            sq += ((x0[0] * x0[0] + x0[1] * x0[1]) + (x0[2] * x0[2] + x0[3] * x0[3])) + ((x1[0] * x1[0] + x1[1] * x1[1]) + (x1[2] * x1[2] + x1[3] * x1[3]));
                        }
                    }
                    if constexpr (XBF) { sq += shx(sq, 16); sq += shx(sq, 32); sso[(size_t)(row0 + ai * HALF + m * 16) * 32 + u.pn * 4 + wc] = sq; }
                }
            }
        } else if constexpr (MODE == 4) {
            float rq[2][4], mw[2][4], sw[2][4];
            {   f32x4 q4[2][4];
#pragma unroll
                for (int ai = 0; ai < 2; ++ai)
#pragma unroll
                    for (int m = 0; m < 4; ++m) q4[ai][m] = *(const f32x4*)(ss + ((size_t)(row0 + ai * HALF + m * 16) * 32 + 8 * u.pn + 2 * fq) * 2);
#pragma unroll
                for (int ai = 0; ai < 2; ++ai)
#pragma unroll
                    for (int m = 0; m < 4; ++m) { float t = q4[ai][m][1] + q4[ai][m][3]; t += shx(t, 16); t += shx(t, 32); rq[ai][m] = 1.0f / sqrtf(t * (1.0f / 512.0f) + EPS_); } }
            typedef float f32x2v __attribute__((ext_vector_type(2)));
            LAS f32x2v* X2 = (LAS f32x2v*)xch;
#pragma unroll
            for (int ai = 0; ai < 2; ++ai)
#pragma unroll
                for (int m = 0; m < 4; ++m) {
                    const float r = rq[ai][m]; float mx = -1e30f;
#pragma unroll
                    for (int bj = 0; bj < 2; ++bj)
#pragma unroll
                        for (int n = 0; n < 2; ++n)
#pragma unroll
                            for (int e = 0; e < 4; ++e) mx = fmaxf(mx, acc[ai][bj][m][n][e] * r);
                    mx = fmaxf(mx, shx(mx, 16)); mx = fmaxf(mx, shx(mx, 32));
                    float sm = 0.f;
#pragma unroll
                    for (int bj = 0; bj < 2; ++bj)
#pragma unroll
                        for (int n = 0; n < 2; ++n)
#pragma unroll
                            for (int e = 0; e < 4; ++e) sm += fast_exp(acc[ai][bj][m][n][e] * r - mx);
                    sm += shx(sm, 16); sm += shx(sm, 32);
                    mw[ai][m] = mx; sw[ai][m] = sm;
                    X2[(ai * HALF + wr * 64 + m * 16 + fr) * 4 + wc] = (f32x2v){mx, sm};
                }
            asm volatile("s_waitcnt lgkmcnt(0)" ::: "memory"); __builtin_amdgcn_s_barrier(); asm volatile("" ::: "memory");
            bf16_t* O = (bf16_t*)out; const int col0 = u.pn * BM + wc * 32 + 8 * fq;
#pragma unroll
            for (int ai = 0; ai < 2; ++ai)
#pragma unroll
                for (int m = 0; m < 4; ++m) {
                    const LAS f32x4* xp = (const LAS f32x4*)(X2 + (ai * HALF + wr * 64 + m * 16 + fr) * 4);
                    const f32x4 p0 = xp[0], p1 = xp[1];
                    const float M = fmaxf(fmaxf(p0[0], p0[2]), fmaxf(p1[0], p1[2]));
                    const float tot = (p0[1] * fast_exp(p0[0] - M) + p0[3] * fast_exp(p0[2] - M)) + (p1[1] * fast_exp(p1[0] - M) + p1[3] * fast_exp(p1[2] - M));
                    const float r = rq[ai][m], mo = mw[ai][m], f = fast_exp(mo - M) / tot;
#pragma unroll
                    for (int bj = 0; bj < 2; ++bj) {
                        const f32x4 v0 = acc[ai][bj][m][0], v1 = acc[ai][bj][m][1]; u32x4 w;
                        w.x = cvt_pk_bf16(fast_exp(v0[0] * r - mo) * f, fast_exp(v0[1] * r - mo) * f); w.y = cvt_pk_bf16(fast_exp(v0[2] * r - mo) * f, fast_exp(v0[3] * r - mo) * f);
                        w.z = cvt_pk_bf16(fast_exp(v1[0] * r - mo) * f, fast_exp(v1[1] * r - mo) * f); w.w = cvt_pk_bf16(fast_exp(v1[2] * r - mo) * f, fast_exp(v1[3] * r - mo) * f);
                        *(u32x4*)(O + (size_t)(row0 + ai * HALF + m * 16) * ldc + col0 + bj * HALF) = w;
                    }
                }
            (void)sw;
        } else {
            const int col0 = u.pn * BM + wc * 32 + 8 * fq;
            if constexpr (MODE == 0 && HN) {
                if (u.pn < 8) {
                    LAS float* X = (LAS float*)xch + (wr * 64 + fr) * 8 + wc;
#pragma unroll
                    for (int ai = 0; ai < 2; ++ai)
#pragma unroll
                        for (int m = 0; m < 4; ++m)
#pragma unroll
                            for (int bj = 0; bj < 2; ++bj) { const f32x4 v0 = acc[ai][bj][m][0] * rs[ai][m], v1 = acc[ai][bj][m][1] * rs[ai][m];
                                float t = ((v0[0] * v0[0] + v0[1] * v0[1]) + (v0[2] * v0[2] + v0[3] * v0[3])) + ((v1[0] * v1[0] + v1[1] * v1[1]) + (v1[2] * v1[2] + v1[3] * v1[3]));
                                t += shx(t, 16); t += shx(t, 32); X[(ai * HALF + m * 16) * 8 + bj * 4] = t; }
                    asm volatile("s_waitcnt lgkmcnt(0)" ::: "memory"); __builtin_amdgcn_s_barrier(); asm volatile("" ::: "memory");
                    f32x4 g0 = (f32x4){1.f, 1.f, 1.f, 1.f}, g1 = g0;
                    if (u.pn >= 4) { g0 = *(const f32x4*)(base + wc * 32 + 8 * fq); g1 = *(const f32x4*)(base + wc * 32 + 8 * fq + 4); }
#pragma unroll
                    for (int ai = 0; ai < 2; ++ai)
#pragma unroll
                        for (int m = 0; m < 4; ++m) {
                            const size_t roff = (size_t)(row0 + ai * HALF + m * 16) * ldc + col0;
#pragma unroll
                            for (int bj = 0; bj < 2; ++bj) { const f32x4 p = *(const LAS f32x4*)((LAS float*)xch + (wr * 64 + fr + ai * HALF + m * 16) * 8 + bj * 4);
                                const float r = rs[ai][m] / sqrtf(((p[0] + p[1]) + (p[2] + p[3])) * (1.0f / 128.0f) + EPS_);
                                const f32x4 v0 = acc[ai][bj][m][0] * r * g0, v1 = acc[ai][bj][m][1] * r * g1;
                                u32x4 w; w.x = cvt_pk_bf16(v0[0], v0[1]); w.y = cvt_pk_bf16(v0[2], v0[3]); w.z = cvt_pk_bf16(v1[0], v1[1]); w.w = cvt_pk_bf16(v1[2], v1[3]);
                                *(u32x4*)((bf16_t*)out + roff + bj * HALF) = w; }
                        }
                    return;
                }
            }
            const bool do_gelu = (MODE == 0) && (u.pn >= gelu_pn);
#pragma unroll
            for (int ai = 0; ai < 2; ++ai)
#pragma unroll
                for (int m = 0; m < 4; ++m) {
                    const size_t roff = (size_t)(row0 + ai * HALF + m * 16) * ldc + col0;
                    float s1 = 0.f, s2 = 0.f;
#pragma unroll
                    for (int bj = 0; bj < 2; ++bj) {
                        f32x4 v0 = acc[ai][bj][m][0], v1 = acc[ai][bj][m][1];
                        if constexpr (MODE == 0) {
                            v0 = v0 * rs[ai][m]; v1 = v1 * rs[ai][m];
                            if (do_gelu) {
#pragma unroll
                                for (int e = 0; e < 4; ++e) { v0[e] = gelu_f(v0[e]); v1[e] = gelu_f(v1[e]); }
                            }
                            if constexpr (STATS) {
                                s1 += ((v0[0] + v0[1]) + (v0[2] + v0[3])) + ((v1[0] + v1[1]) + (v1[2] + v1[3]));
                                s2 += ((v0[0] * v0[0] + v0[1] * v0[1]) + (v0[2] * v0[2] + v0[3] * v0[3])) + ((v1[0] * v1[0] + v1[1] * v1[1]) + (v1[2] * v1[2] + v1[3] * v1[3]));
                            }
                            u32x4 w; w.x = cvt_pk_bf16(v0[0], v0[1]); w.y = cvt_pk_bf16(v0[2], v0[3]); w.z = cvt_pk_bf16(v1[0], v1[1]); w.w = cvt_pk_bf16(v1[2], v1[3]);
                            *(u32x4*)((bf16_t*)out + roff + bj * HALF) = w;
                        } else {
                            *(f32x4*)((float*)out + roff + bj * HALF) = v0 * scale; *(f32x4*)((float*)out + roff + bj * HALF + 4) = v1 * scale;
                        }
                    }
                    if constexpr (MODE == 0 && STATS) {
                        s1 += shx(s1, 16); s1 += shx(s1, 32); s2 += shx(s2, 16); s2 += shx(s2, 32);
                        if (u.pn >= st_pn0) *(f32x2*)(st + ((size_t)(row0 + ai * HALF + m * 16) * st_n + 4 * (u.pn - st_pn0) + wc) * 2) = (f32x2){s1, s2};
                    }
                }
        }
    }
};

template <class EpiT>
__device__ __forceinline__ void gemm_phase(LAS unsigned char* lds, const Gemm g, const EpiT& E) {
    int tid = threadIdx.x; asm volatile("" : "+v"(tid));
    const int wid = __builtin_amdgcn_readfirstlane(tid >> 6), lane = tid & 63, wr = wid >> 2, wc = wid & 3, fr = lane & 15, fq = lane >> 4;
    constexpr int KS = EpiT::MIDK ? 2 : 1;
    const int K = g.K, nt = K / BK / KS;
    const unsigned segstep = (unsigned)(nt * BK * 2);
    const int G_ = g.vG > 0 ? g.vG : (int)gridDim.x;
    int bx_ = (int)((blockIdx.x + (unsigned)g.bx_off) % (unsigned)G_); asm volatile("" : "+s"(bx_));
    StaticOrder S; S.init(g.nM, g.nN, G_, bx_);
    unsigned voffA[2], voffB[2];
#pragma unroll
    for (int i = 0; i < 2; ++i) { int R, C; stage_rc(tid * 16 + i * 8192, R, C); const int Rb = (R & ~31) + perm32(R & 31);
        voffA[i] = (unsigned)(R * g.lda + C) * 2u; voffB[i] = (unsigned)(Rb * g.ldb + C) * 2u; }
    const size_t kstep = (size_t)(BK * 2);
    const unsigned hstepA = (unsigned)HALF * g.lda * 2u, hstepB = (unsigned)HALF * g.ldb * 2u;
    const unsigned ldsw = (unsigned)wid * 1024u;
    const int aoff = lds_byte(wr * 64 + fr, fq * 8), boff = lds_byte(wc * 32 + fr, fq * 8);
#define PG8_SA(b, h) (((b) * 2 + (h)) * HTB)
#define PG8_SB(b, h) ((4 + (b) * 2 + (h)) * HTB)
#define PG8_STAGE(bufoff, gbase, voff) do { _Pragma("unroll") for (int _i = 0; _i < 2; ++_i) \
        __builtin_amdgcn_global_load_lds((const unsigned*)((const char*)(gbase) + (voff)[_i]), (LAS unsigned*)(lds + (bufoff) + ldsw + _i * 8192), 16, 0, 0); } while (0)
#define PG8_LDA(dst, b, h) do { _Pragma("unroll") for (int m = 0; m < 4; ++m) _Pragma("unroll") for (int k = 0; k < 2; ++k) dst[m][k] = *(const LAS bf16x8*)(lds + PG8_SA(b, h) + aoff + m * 2048 + k * 1024); } while (0)
#define PG8_LDB(dst, b, h) do { _Pragma("unroll") for (int n = 0; n < 2; ++n) _Pragma("unroll") for (int k = 0; k < 2; ++k) dst[n][k] = *(const LAS bf16x8*)(lds + PG8_SB(b, h) + boff + n * 2048 + k * 1024); } while (0)
#define PG8_MMA(ai, bj, At, Bt) do { __builtin_amdgcn_s_setprio(1); _Pragma("unroll") for (int m = 0; m < 4; ++m) _Pragma("unroll") for (int n = 0; n < 2; ++n) _Pragma("unroll") for (int k = 0; k < 2; ++k) \
        acc[ai][bj][m][n] = __builtin_amdgcn_mfma_f32_16x16x32_bf16(Bt[n][k], At[m][k], acc[ai][bj][m][n], 0, 0, 0); __builtin_amdgcn_s_setprio(0); } while (0)
#define PG8_WAIT_V(n) asm volatile("s_waitcnt vmcnt(" #n ")" ::: "memory")
#define PG8_WAIT_L(n) asm volatile("s_waitcnt lgkmcnt(" #n ")" ::: "memory")
#define PG8_BAR __builtin_amdgcn_s_barrier()
#define PG8_SCHED __builtin_amdgcn_sched_barrier(0)
    Unit cur, nxt; int ui = 0;
    if (!S.next(0, cur)) return;
    f32x4 acc[2][2][4][2];
#pragma unroll
    for (int a = 0; a < 2; ++a)
#pragma unroll
        for (int b = 0; b < 2; ++b)
#pragma unroll
            for (int m = 0; m < 4; ++m)
#pragma unroll
                for (int n = 0; n < 2; ++n) acc[a][b][m][n] = (f32x4){0.f, 0.f, 0.f, 0.f};
    bf16x8 At[4][2], B0[2][2], B1[2][2];
    const char* cA = (const char*)g.A + (size_t)((unsigned)cur.pm * g.a_pm + (unsigned)cur.pn * g.a_pn); const char* cB = (const char*)g.Bt + (size_t)((unsigned)cur.pm * g.b_pm + (unsigned)cur.pn * g.b_pn);
    PG8_STAGE(PG8_SB(0, 0), cB, voffB); PG8_STAGE(PG8_SB(0, 1), cB + hstepB, voffB); PG8_STAGE(PG8_SA(0, 0), cA, voffA); PG8_STAGE(PG8_SA(0, 1), cA + hstepA, voffA);
    if (wr == 1) PG8_BAR;
    PG8_WAIT_V(2); PG8_BAR;
    PG8_STAGE(PG8_SB(1, 0), cB + kstep, voffB); PG8_STAGE(PG8_SA(1, 0), cA + kstep, voffA); PG8_STAGE(PG8_SB(1, 1), cB + hstepB + kstep, voffB);
    PG8_WAIT_V(6); PG8_BAR;
    for (;;) {
        const bool seg0 = (KS == 2) && ((ui & 1) == 0);
        bool has_next; const char* nA; const char* nB;
        if (seg0) { has_next = true; nxt = cur; nA = cA + segstep; nB = cB + segstep; }
        else {
            has_next = S.next((ui + 1) / KS, nxt);
            nA = has_next ? (const char*)g.A + (size_t)((unsigned)nxt.pm * g.a_pm + (unsigned)nxt.pn * g.a_pn) : cA;
            nB = has_next ? (const char*)g.Bt + (size_t)((unsigned)nxt.pm * g.b_pm + (unsigned)nxt.pn * g.b_pn) : cB;
        }
        for (int t = 0; t < nt; t += 2) {
            const bool last = (t == nt - 2);
            const char* a1 = cA + (size_t)(t + 1) * kstep;
            const char* a2 = last ? nA : cA + (size_t)(t + 2) * kstep; const char* b2 = last ? nB : cB + (size_t)(t + 2) * kstep;
            const char* a3 = a2 + kstep; const char* b3 = b2 + kstep;
            PG8_LDB(B0, 0, 0); PG8_LDB(B1, 0, 1); PG8_SCHED; PG8_LDA(At, 0, 0); PG8_STAGE(PG8_SA(1, 1), a1 + hstepA, voffA);
            PG8_WAIT_V(8); PG8_WAIT_L(0); PG8_BAR; PG8_MMA(0, 0, At, B0); PG8_MMA(0, 1, At, B1); PG8_BAR; PG8_SCHED;
            PG8_LDA(At, 0, 1); PG8_STAGE(PG8_SB(0, 0), b2, voffB); PG8_STAGE(PG8_SB(0, 1), b2 + hstepB, voffB); PG8_STAGE(PG8_SA(0, 0), a2, voffA);
            PG8_WAIT_V(8); PG8_WAIT_L(0); PG8_BAR; PG8_MMA(1, 0, At, B0); PG8_MMA(1, 1, At, B1); PG8_BAR; PG8_SCHED;
            PG8_LDB(B0, 1, 0); PG8_LDB(B1, 1, 1); PG8_SCHED; PG8_LDA(At, 1, 0); PG8_STAGE(PG8_SA(0, 1), a2 + hstepA, voffA);
            PG8_WAIT_V(8); PG8_WAIT_L(0); PG8_BAR; PG8_MMA(0, 0, At, B0); PG8_MMA(0, 1, At, B1); PG8_BAR; PG8_SCHED;
            PG8_LDA(At, 1, 1); PG8_STAGE(PG8_SB(1, 0), b3, voffB); PG8_STAGE(PG8_SB(1, 1), b3 + hstepB, voffB); PG8_STAGE(PG8_SA(1, 0), a3, voffA);
            PG8_WAIT_V(8); PG8_WAIT_L(0); PG8_BAR; PG8_MMA(1, 0, At, B0); PG8_MMA(1, 1, At, B1); PG8_BAR; PG8_SCHED;
        }
        const int l2_ = (int)__builtin_amdgcn_mbcnt_hi(~0u, __builtin_amdgcn_mbcnt_lo(~0u, 0u)), fr2 = l2_ & 15, fq2 = l2_ >> 4;
        Unit cu2 = cur; asm volatile("" : "+s"(cu2.pm), "+s"(cu2.pn));
        if (!seg0) {
            if (wr == 0) PG8_BAR;
            E(acc, cu2, wr, wc, fr2, fq2);
            if (!has_next) break;
        }
        if constexpr (EpiT::MIDK) {
            float fm[2][4];
#pragma unroll
            for (int ai = 0; ai < 2; ++ai)
#pragma unroll
                for (int m = 0; m < 4; ++m) fm[ai][m] = 0.f;
            if (seg0) E.midk_factors(fm, cu2, wr, fr2, fq2);
#pragma unroll
            for (int ai = 0; ai < 2; ++ai)
#pragma unroll
                for (int bj = 0; bj < 2; ++bj)
#pragma unroll
                    for (int m = 0; m < 4; ++m)
#pragma unroll
                        for (int n = 0; n < 2; ++n) acc[ai][bj][m][n] = acc[ai][bj][m][n] * fm[ai][m];
        } else {
#pragma unroll
            for (int a = 0; a < 2; ++a)
#pragma unroll
                for (int b = 0; b < 2; ++b)
#pragma unroll
                    for (int m = 0; m < 4; ++m)
#pragma unroll
                        for (int n = 0; n < 2; ++n) acc[a][b][m][n] = (f32x4){0.f, 0.f, 0.f, 0.f};
        }
        cur = nxt; cA = nA; cB = nB; ++ui;
        if (!seg0) { if (wr == 1) PG8_BAR; }
    }
    PG8_WAIT_V(0);
    PG8_BAR;
#undef PG8_SA
#undef PG8_SB
#undef PG8_STAGE
#undef PG8_LDA
#undef PG8_LDB
#undef PG8_MMA
#undef PG8_WAIT_V
#undef PG8_WAIT_L
#undef PG8_BAR
#undef PG8_SCHED
}
}

#define XB_TMO      128
#define XB_XCNT(j)  (256  + 64 * (j))
#define XB_XSUB(j)  (1280 + 64 * (j))
#define XB_XGEN(j)  (2304 + 64 * (j))
#define XB_TOP      3328
#define XB_TOPGEN   3392
#define XCD_BAR_WORDS 3456
#define XB_SPIN_CAP (1u << 20)
__device__ __forceinline__ unsigned xb_ld(unsigned* p)              { return __hip_atomic_load(p, __ATOMIC_RELAXED, __HIP_MEMORY_SCOPE_AGENT); }
__device__ __forceinline__ unsigned xb_add(unsigned* p, unsigned v) { return __hip_atomic_fetch_add(p, v, __ATOMIC_RELAXED, __HIP_MEMORY_SCOPE_AGENT); }
__device__ __forceinline__ unsigned xb_xcc_id() { return (unsigned)__builtin_amdgcn_s_getreg((3 << 11) | 20) & 0xFu; }
#define XB_SPIN(cond, bar) do { unsigned _sp = 0; while (cond) { __builtin_amdgcn_s_sleep(1); \
    if ((++_sp & 255u) == 0u) { if (xb_ld(&(bar)[XB_TMO])) break; if (_sp > XB_SPIN_CAP) { atomicAdd(&(bar)[XB_TMO], 1u); break; } } } } while (0)
struct XcdBarrier { unsigned* bar; unsigned x; volatile LAS unsigned* st; };
__device__ __forceinline__ XcdBarrier xcd_barrier_post(unsigned* bar, volatile LAS unsigned* st) {
    XcdBarrier b; b.bar = bar; b.x = (unsigned)__builtin_amdgcn_readfirstlane((int)xb_xcc_id()); b.st = st;
    if (threadIdx.x == 0) (void)xb_add(&bar[XB_XCNT(b.x)], 1u);
    return b;
}
__device__ __forceinline__ void xcd_barrier_complete(unsigned* bar, unsigned x, unsigned& nloc, unsigned& nx) {
    const unsigned G = gridDim.x * gridDim.y * gridDim.z;
    unsigned sum, cnt, mine, sp = 0u;
    for (;;) {
        sum = 0u; cnt = 0u;
#pragma unroll 1
        for (unsigned j = 0; j < 16; ++j) { const unsigned c = xb_ld(&bar[XB_XCNT(j)]); sum += c; cnt += (c > 0u) ? 1u : 0u; }
        mine = xb_ld(&bar[XB_XCNT(x)]);
        if (sum == G) break;
        __builtin_amdgcn_s_sleep(1);
        if ((++sp & 255u) == 0u) { if (xb_ld(&bar[XB_TMO])) break; if (sp > XB_SPIN_CAP) { atomicAdd(&bar[XB_TMO], 1u); break; } }
    }
    nloc = mine > 0u ? mine : 1u; nx = cnt > 0u ? cnt : 1u;
}
__device__ __forceinline__ void xcd_barrier(const XcdBarrier& b) {
    asm volatile("s_waitcnt vmcnt(0)" ::: "memory");
    __syncthreads();
    if (threadIdx.x == 0) {
        unsigned* bar = b.bar; unsigned bx = b.x; asm volatile("" : "+s"(bx));
        __builtin_amdgcn_s_waitcnt(0);
        unsigned nloc = b.st[0], nx = b.st[1];
        if (nloc == 0u) { xcd_barrier_complete(bar, bx, nloc, nx); b.st[0] = nloc; b.st[1] = nx; }
        const unsigned old = xb_add(&bar[XB_XSUB(bx)], 1u);
        const unsigned gen = old / nloc;
        if (old + 1u == (gen + 1u) * nloc) {
            __builtin_amdgcn_fence(__ATOMIC_RELEASE, "agent");
            asm volatile("s_waitcnt vmcnt(0)" ::: "memory");
            const unsigned og = xb_add(&bar[XB_TOP], 1u);
            const unsigned tg = og / nx;
            if (og + 1u == (tg + 1u) * nx) xb_add(&bar[XB_TOPGEN], 1u);
            else XB_SPIN(xb_ld(&bar[XB_TOPGEN]) == tg, bar);
            __builtin_amdgcn_fence(__ATOMIC_ACQUIRE, "agent");
            xb_add(&bar[XB_XGEN(bx)], 1u);
            asm volatile("s_waitcnt vmcnt(0)" ::: "memory");
        } else {
            XB_SPIN(xb_ld(&bar[XB_XGEN(bx)]) == gen, bar);
            __builtin_amdgcn_fence(__ATOMIC_ACQUIRE, "agent");
            asm volatile("s_waitcnt vmcnt(0)" ::: "memory");
        }
    }
    __syncthreads();
}

struct Args { const float* in[27]; float* out; unsigned char* ws; };
enum { I_X = 0, I_MEM, I_G_FFN1, I_W_FFN1_IN, I_W_FFN1_OUT, I_G_MIX, I_W_IN, I_G_Q_A, I_G_K_A, I_REL, I_LN_G, I_LN_B, I_W_S, I_B_S, I_G_OUT_A, I_G_OUT_B, I_W_OUT,
       I_G_MEM_Q, I_G_MEM_KV, I_W_MEM_Q, I_W_MEM_KV, I_W_MEM_O, I_G_Q_MEM, I_G_K_MEM, I_G_FFN2, I_W_FFN2_IN, I_W_FFN2_OUT };

__device__ __forceinline__ void rms_rows_2048(const float* x, const float* g, bf16_t* o, int nrows, int gw, int NGW, int lane) {
    for (int r = gw; r < nrows; r += NGW) {
        const f32x4* xr = (const f32x4*)(x + (size_t)r * 2048) + lane;
        f32x4 v[8]; float s = 0.f;
#pragma unroll
        for (int j = 0; j < 8; ++j) { v[j] = xr[64 * j]; s += (v[j][0] * v[j][0] + v[j][1] * v[j][1]) + (v[j][2] * v[j][2] + v[j][3] * v[j][3]); }
        const float rstd = 1.0f / sqrtf(wave_sum(s) * (1.0f / 2048.0f) + EPS_);
        u32x2* op = (u32x2*)(o + (size_t)r * 2048) + lane;
#pragma unroll
        for (int j = 0; j < 8; ++j) { const f32x4 gv = ((const f32x4*)g)[lane + 64 * j]; u32x2 w; w.x = cvt_pk_bf16(v[j][0] * rstd * gv[0], v[j][1] * rstd * gv[1]); w.y = cvt_pk_bf16(v[j][2] * rstd * gv[2], v[j][3] * rstd * gv[3]); op[64 * j] = w; }
    }
}
__device__ __forceinline__ void rows_bf16_ss(const float* x, bf16_t* o, float* ss, int nrows, int gw, int NGW, int lane) {
    for (int r = gw; r < nrows; r += 2 * NGW) {
        const f32x4* xr0 = (const f32x4*)(x + (size_t)r * 2048) + lane; const f32x4* xr1 = (const f32x4*)(x + (size_t)(r + NGW) * 2048) + lane;
        u32x2* op0 = (u32x2*)(o + (size_t)r * 2048) + lane; u32x2* op1 = (u32x2*)(o + (size_t)(r + NGW) * 2048) + lane; float s0 = 0.f, s1 = 0.f;
        f32x4 v0[8], v1[8];
#pragma unroll
        for (int j = 0; j < 8; ++j) { v0[j] = xr0[64 * j]; v1[j] = xr1[64 * j]; }
#pragma unroll
        for (int j = 0; j < 8; ++j) { const f32x4 a = v0[j], b = v1[j]; s0 += (a[0] * a[0] + a[1] * a[1]) + (a[2] * a[2] + a[3] * a[3]); s1 += (b[0] * b[0] + b[1] * b[1]) + (b[2] * b[2] + b[3] * b[3]);
            u32x2 w; w.x = cvt_pk_bf16(a[0], a[1]); w.y = cvt_pk_bf16(a[2], a[3]); op0[64 * j] = w; w.x = cvt_pk_bf16(b[0], b[1]); w.y = cvt_pk_bf16(b[2], b[3]); op1[64 * j] = w; }
        s0 = wave_sum(s0); s1 = wave_sum(s1);
        if (lane < 32) { ss[(size_t)r * 32 + lane] = (lane == 0) ? s0 : 0.f; ss[(size_t)(r + NGW) * 32 + lane] = (lane == 0) ? s1 : 0.f; }
    }
}
__device__ __forceinline__ void headnorm512_rows(const bf16_t* src, int lds_, bf16_t* dst, int ldd, const float* g, const float* g2, float scale, int nrows, int gw, int NGW, int lane) {
    const int h = lane >> 4, li = lane & 15;
    for (int r = gw; r < nrows; r += NGW) {
        const u32x4* sp = (const u32x4*)(src + (size_t)r * lds_ + h * 512) + li;
        u32x4 v[4]; float s = 0.f;
#pragma unroll
        for (int i = 0; i < 4; ++i) { v[i] = sp[16 * i];
#pragma unroll
            for (int e = 0; e < 4; ++e) { const float a = bf_lo(v[i][e]), b = bf_hi(v[i][e]); s += a * a + b * b; } }
        s += shx(s, 1); s += shx(s, 2); s += shx(s, 4); s += shx(s, 8);
        const float rstd = scale / sqrtf(s * (1.0f / 512.0f) + EPS_);
        u32x4* dp = (u32x4*)(dst + (size_t)r * ldd + h * 512) + li;
#pragma unroll
        for (int i = 0; i < 4; ++i) { f32x4 g0 = *(const f32x4*)(g + (li + 16 * i) * 8), g1 = *(const f32x4*)(g + (li + 16 * i) * 8 + 4); u32x4 w;
            if (g2) { g0 = g0 * *(const f32x4*)(g2 + (li + 16 * i) * 8); g1 = g1 * *(const f32x4*)(g2 + (li + 16 * i) * 8 + 4); }
            w.x = cvt_pk_bf16(bf_lo(v[i].x) * rstd * g0[0], bf_hi(v[i].x) * rstd * g0[1]); w.y = cvt_pk_bf16(bf_lo(v[i].y) * rstd * g0[2], bf_hi(v[i].y) * rstd * g0[3]);
            w.z = cvt_pk_bf16(bf_lo(v[i].z) * rstd * g1[0], bf_hi(v[i].z) * rstd * g1[1]); w.w = cvt_pk_bf16(bf_lo(v[i].w) * rstd * g1[2], bf_hi(v[i].w) * rstd * g1[3]);
            dp[16 * i] = w; }
    }
}
__device__ __forceinline__ void zpost_rows(bf16_t* Z, const float* gq, const float* gk, const float* lng, const float* lnb, int gw, int NGW, int lane) {
    const int li = lane & 15;
    for (int r = gw; r < S_; r += NGW) {
        bf16_t* zr = Z + (size_t)r * NIN_;
#pragma unroll
        for (int p = 0; p < 4; ++p) {
            u32x4* ptr = (u32x4*)zr + p * 64 + lane;
            const u32x4 v = *ptr; float s = 0.f;
#pragma unroll
            for (int e = 0; e < 4; ++e) { const float a = bf_lo(v[e]), b = bf_hi(v[e]); s += a * a + b * b; }
            s += shx(s, 1); s += shx(s, 2); s += shx(s, 4); s += shx(s, 8);
            const float rstd = (p < 2 ? 0.08838834764831845f : 1.0f) / sqrtf(s * (1.0f / 128.0f) + EPS_);
            const float* g = (p < 2 ? gq : gk) + li * 8;
            const f32x4 g0 = *(const f32x4*)g, g1 = *(const f32x4*)(g + 4); u32x4 w;
            w.x = cvt_pk_bf16(bf_lo(v.x) * rstd * g0[0], bf_hi(v.x) * rstd * g0[1]); w.y = cvt_pk_bf16(bf_lo(v.y) * rstd * g0[2], bf_hi(v.y) * rstd * g0[3]);
            w.z = cvt_pk_bf16(bf_lo(v.z) * rstd * g1[0], bf_hi(v.z) * rstd * g1[1]); w.w = cvt_pk_bf16(bf_lo(v.w) * rstd * g1[2], bf_hi(v.w) * rstd * g1[3]);
            *ptr = w;
        }
        u32x4* vp = (u32x4*)(zr + 4096) + lane;
        u32x4 v[2]; float f[16]; float s = 0.f;
#pragma unroll
        for (int i = 0; i < 2; ++i) { v[i] = vp[64 * i];
#pragma unroll
            for (int e = 0; e < 4; ++e) { f[i * 8 + 2 * e] = bf_lo(v[i][e]); f[i * 8 + 2 * e + 1] = bf_hi(v[i][e]); s += f[i * 8 + 2 * e] + f[i * 8 + 2 * e + 1]; } }
        const float mu = wave_sum(s) * (1.0f / 1024.0f); float q = 0.f;
#pragma unroll
        for (int e = 0; e < 16; ++e) { f[e] -= mu; q += f[e] * f[e]; }
        const float rstd = 1.0f / sqrtf(wave_sum(q) * (1.0f / 1024.0f) + EPS_);
#pragma unroll
        for (int i = 0; i < 2; ++i) { const int c0 = (lane + 64 * i) * 8; u32x4 w;
            const f32x4 g0 = *(const f32x4*)(lng + c0), g1 = *(const f32x4*)(lng + c0 + 4), b0 = *(const f32x4*)(lnb + c0), b1 = *(const f32x4*)(lnb + c0 + 4);
            w.x = cvt_pk_bf16(f[i * 8 + 0] * rstd * g0[0] + b0[0], f[i * 8 + 1] * rstd * g0[1] + b0[1]); w.y = cvt_pk_bf16(f[i * 8 + 2] * rstd * g0[2] + b0[2], f[i * 8 + 3] * rstd * g0[3] + b0[3]);
            w.z = cvt_pk_bf16(f[i * 8 + 4] * rstd * g1[0] + b1[0], f[i * 8 + 5] * rstd * g1[1] + b1[1]); w.w = cvt_pk_bf16(f[i * 8 + 6] * rstd * g1[2] + b1[2], f[i * 8 + 7] * rstd * g1[3] + b1[3]);
            vp[64 * i] = w; }
    }
}
__device__ __forceinline__ void ynorm_rows(bf16_t* Y, const float* ga, const float* gb, int gw, int NGW, int lane) {
    const int hf = lane >> 5, li = lane & 31; const float* g = hf ? gb : ga;
    for (int r = gw; r < S_; r += 2 * NGW) {
        u32x4* yp0 = (u32x4*)(Y + (size_t)r * 2048 + hf * 1024) + li; u32x4* yp1 = (u32x4*)(Y + (size_t)(r + NGW) * 2048 + hf * 1024) + li;
        u32x4 v[2][4]; float s[2] = {0.f, 0.f};
#pragma unroll
        for (int i = 0; i < 4; ++i) { v[0][i] = yp0[32 * i]; v[1][i] = yp1[32 * i]; }
#pragma unroll
        for (int k = 0; k < 2; ++k) {
#pragma unroll
            for (int i = 0; i < 4; ++i)
#pragma unroll
                for (int e = 0; e < 4; ++e) { const float a = bf_lo(v[k][i][e]), b = bf_hi(v[k][i][e]); s[k] += a * a + b * b; }
            s[k] += shx(s[k], 1); s[k] += shx(s[k], 2); s[k] += shx(s[k], 4); s[k] += shx(s[k], 8); s[k] += shx(s[k], 16);
            s[k] = 1.0f / sqrtf(s[k] * (1.0f / 1024.0f) + EPS_); }
#pragma unroll
        for (int i = 0; i < 4; ++i) { const int c0 = (li + 32 * i) * 8; const f32x4 g0 = *(const f32x4*)(g + c0), g1 = *(const f32x4*)(g + c0 + 4);
#pragma unroll
            for (int k = 0; k < 2; ++k) { const float rstd = s[k]; const u32x4 q = v[k][i]; u32x4 w;
                w.x = cvt_pk_bf16(bf_lo(q.x) * rstd * g0[0], bf_hi(q.x) * rstd * g0[1]); w.y = cvt_pk_bf16(bf_lo(q.y) * rstd * g0[2], bf_hi(q.y) * rstd * g0[3]);
                w.z = cvt_pk_bf16(bf_lo(q.z) * rstd * g1[0], bf_hi(q.z) * rstd * g1[1]); w.w = cvt_pk_bf16(bf_lo(q.w) * rstd * g1[2], bf_hi(q.w) * rstd * g1[3]);
                (k ? yp1 : yp0)[32 * i] = w; } }
    }
}
__device__ __forceinline__ void softmax_rows(const float* SC, bf16_t* P, int gw, int NGW, int lane) {
    const int h = lane >> 4, li = lane & 15;
    for (int r = gw; r < S_; r += NGW) {
        const f32x4* sp = (const f32x4*)(SC + (size_t)r * 1024 + h * 256) + li;
        f32x4 v[4]; float mx = -1e30f;
#pragma unroll
        for (int i = 0; i < 4; ++i) { v[i] = sp[16 * i]; mx = fmaxf(mx, fmaxf(fmaxf(v[i][0], v[i][1]), fmaxf(v[i][2], v[i][3]))); }
        mx = fmaxf(mx, shx(mx, 1)); mx = fmaxf(mx, shx(mx, 2)); mx = fmaxf(mx, shx(mx, 4)); mx = fmaxf(mx, shx(mx, 8));
        float s = 0.f;
#pragma unroll
        for (int i = 0; i < 4; ++i)
#pragma unroll
            for (int e = 0; e < 4; ++e) { v[i][e] = fast_exp(v[i][e] - mx); s += v[i][e]; }
        s += shx(s, 1); s += shx(s, 2); s += shx(s, 4); s += shx(s, 8);
        const float inv = 1.0f / s;
        u32x2* pp = (u32x2*)(P + (size_t)r * 1024 + h * 256) + li;
#pragma unroll
        for (int i = 0; i < 4; ++i) { u32x2 w; w.x = cvt_pk_bf16(v[i][0] * inv, v[i][1] * inv); w.y = cvt_pk_bf16(v[i][2] * inv, v[i][3] * inv); pp[16 * i] = w; }
    }
}

struct TDesc { const float* src; bf16_t* dst; const float* gk; int N, K; };
__device__ __forceinline__ void t_load(const TDesc& d, int lane, f32x4 (&v)[8], f32x4 (&gv)[2]) {
    const int q = lane & 7, kr = lane >> 3;
#pragma unroll
    for (int j = 0; j < 8; ++j) v[j] = *(const f32x4*)(d.src + (size_t)(8 * j + kr) * d.N + 4 * q);
    if (d.gk) { gv[0] = *(const f32x4*)(d.gk + 8 * q); gv[1] = *(const f32x4*)(d.gk + 8 * q + 4); } else { gv[0] = (f32x4){1.f, 1.f, 1.f, 1.f}; gv[1] = gv[0]; }
}
__device__ __forceinline__ void t_store(const TDesc& d, int lane, const f32x4 (&v)[8], const f32x4 (&gv)[2], LAS float* scr) {
    const int q = lane & 7, kr = lane >> 3;
#pragma unroll
    for (int j = 0; j < 8; ++j) { LAS float* w = scr + (8 * j + kr) * 33 + 4 * q; w[0] = v[j][0]; w[1] = v[j][1]; w[2] = v[j][2]; w[3] = v[j][3]; }
    asm volatile("s_waitcnt lgkmcnt(0)" ::: "memory");
    const int c = q;
#pragma unroll
    for (int j = 0; j < 4; ++j) { const int n = (lane >> 3) + 8 * j; const LAS float* s = scr + (8 * c) * 33 + n;
        u32x4 o; o.x = cvt_pk_bf16(s[0 * 33] * gv[0][0], s[1 * 33] * gv[0][1]); o.y = cvt_pk_bf16(s[2 * 33] * gv[0][2], s[3 * 33] * gv[0][3]);
        o.z = cvt_pk_bf16(s[4 * 33] * gv[1][0], s[5 * 33] * gv[1][1]); o.w = cvt_pk_bf16(s[6 * 33] * gv[1][2], s[7 * 33] * gv[1][3]);
        *(u32x4*)(d.dst + (size_t)n * d.K + 8 * c) = o; }
    asm volatile("s_waitcnt lgkmcnt(0)" ::: "memory");
}
template <int MODE> __device__ __forceinline__ void t_desc(TDesc& d, const float* W, int K, int N, bf16_t* WT, const float* gk, int item) {
    const int nblk = N / 32, kb = item / nblk, nb = item % nblk, n0 = 32 * nb, k0 = 64 * kb;
    int drow0 = n0;
    if (MODE == 1) { const int j0 = n0 < FF_ ? n0 : n0 - FF_; drow0 = (j0 >> 7) * 256 + (j0 & 127) + (n0 < FF_ ? 0 : 128); }
    d.src = W + (size_t)k0 * N + n0; d.dst = WT + (size_t)drow0 * K + k0; d.gk = gk ? gk + k0 : nullptr; d.N = N; d.K = K;
}

constexpr int AT_KS = 0, AT_VT = 17408, AT_TB = 35840;
__device__ __forceinline__ void attn_unit(LAS unsigned char* lds, const bf16_t* Z, bf16_t* Y, float* ys, const float* rel_l, const float* gq, const float* gk, int h, int qg, int tid, int wid, int lane) {
    const int fr = lane & 15, fq = lane >> 4;
    const int R0 = qg * 256, cw = 4 * qg + (wid >> 1);
    __syncthreads();
    LAS float* tb = (LAS float*)(lds + AT_TB);
    for (int i = tid; i < 832; i += 512) tb[i] = rel_l[h * 513 + (i < 512 ? i : 512)];
    bf16x8 Qf[2][4];
#pragma unroll
    for (int qt = 0; qt < 2; ++qt)
#pragma unroll
        for (int ks = 0; ks < 4; ++ks) Qf[qt][ks] = *(const bf16x8*)(Z + (size_t)(R0 + 32 * wid + 16 * qt + fr) * NIN_ + h * 128 + 32 * ks + 8 * fq);
    f32x4 O[8][2];
#pragma unroll
    for (int dt = 0; dt < 8; ++dt) { O[dt][0] = (f32x4){0.f, 0.f, 0.f, 0.f}; O[dt][1] = (f32x4){0.f, 0.f, 0.f, 0.f}; }
    float m_run[2] = {-1e30f, -1e30f}, l_run[2] = {0.f, 0.f};
    const int kc_lo = (4 * qg - 8) > 0 ? (4 * qg - 8) : 0, kc_hi = 4 * qg + 3;
    u32x4 kreg[2], vreg[2];
    const char* Zc = (const char*)Z;
    unsigned koff[2], voff_[2];
#pragma unroll
    for (int i = 0; i < 2; ++i) { const int c = tid + 512 * i; koff[i] = (unsigned)(((c >> 4) * NIN_ + 1024 + h * 128 + (c & 15) * 8) * 2); voff_[i] = (unsigned)(((c >> 4) * NIN_ + 2048 + h * 128 + (c & 15) * 8) * 2); }
#define AT_LOAD(kc) do { const char* zk = Zc + (size_t)(kc) * (size_t)(64 * NIN_ * 2); _Pragma("unroll") for (int i = 0; i < 2; ++i) { \
        kreg[i] = *(const u32x4*)(zk + koff[i]); vreg[i] = *(const u32x4*)(zk + voff_[i]); } } while (0)
    AT_LOAD(kc_lo);
    for (int kc = kc_lo; kc <= kc_hi; ++kc) {
        __syncthreads();
#pragma unroll
        for (int i = 0; i < 2; ++i) { const int c = tid + 512 * i;
            *(LAS u32x4*)(lds + AT_KS + (c >> 4) * 272 + (c & 15) * 16) = kreg[i];
            *(LAS u32x4*)(lds + AT_VT + (c >> 4) * 288 + (c & 15) * 16) = vreg[i]; }
        __syncthreads();
        if (kc < kc_hi) AT_LOAD(kc + 1);
        if (kc >= cw - 8 && kc <= cw) {
            f32x4 st[2][4];
#pragma unroll
            for (int nt = 0; nt < 4; ++nt) {
                st[0][nt] = (f32x4){0.f, 0.f, 0.f, 0.f}; st[1][nt] = (f32x4){0.f, 0.f, 0.f, 0.f};
                bf16x8 kf[4];
#pragma unroll
                for (int ks = 0; ks < 4; ++ks) kf[ks] = *(const LAS bf16x8*)(lds + AT_KS + (16 * nt + fr) * 272 + (32 * ks + 8 * fq) * 2);
#pragma unroll
                for (int ks = 0; ks < 4; ++ks) { st[0][nt] = __builtin_amdgcn_mfma_f32_16x16x32_bf16(kf[ks], Qf[0][ks], st[0][nt], 0, 0, 0); st[1][nt] = __builtin_amdgcn_mfma_f32_16x16x32_bf16(kf[ks], Qf[1][ks], st[1][nt], 0, 0, 0); }
                __builtin_amdgcn_sched_barrier(0);
            }
            bf16x8 pf[2][2];
#pragma unroll
            for (int qt = 0; qt < 2; ++qt) {
                const LAS float* tbq = tb + ((cw - kc) * 64 + 32 * (wid & 1) + 16 * qt + fr - 4 * fq + 256 - 63);
                float mx = -1e30f;
#pragma unroll
                for (int nt = 0; nt < 4; ++nt)
#pragma unroll
                    for (int jj = 0; jj < 4; ++jj) { const float s = st[qt][nt][jj] + tbq[63 - 16 * nt - jj]; st[qt][nt][jj] = s; mx = fmaxf(mx, s); }
                mx = fmaxf(mx, shx(mx, 16)); mx = fmaxf(mx, shx(mx, 32));
                const float m_new = fmaxf(m_run[qt], mx), alpha = fast_exp(m_run[qt] - m_new);
                float sum = 0.f;
#pragma unroll
                for (int nt = 0; nt < 4; ++nt)
#pragma unroll
                    for (int jj = 0; jj < 4; ++jj) { const float p = fast_exp(st[qt][nt][jj] - m_new); st[qt][nt][jj] = p; sum += p; }
                sum += shx(sum, 16); sum += shx(sum, 32);
                l_run[qt] = l_run[qt] * alpha + sum; m_run[qt] = m_new;
#pragma unroll
                for (int dt = 0; dt < 8; ++dt) O[dt][qt] = O[dt][qt] * alpha;
#pragma unroll
                for (int k2 = 0; k2 < 2; ++k2) { u32x4 w; w.x = cvt_pk_bf16(st[qt][2 * k2][0], st[qt][2 * k2][1]); w.y = cvt_pk_bf16(st[qt][2 * k2][2], st[qt][2 * k2][3]);
                    w.z = cvt_pk_bf16(st[qt][2 * k2 + 1][0], st[qt][2 * k2 + 1][1]); w.w = cvt_pk_bf16(st[qt][2 * k2 + 1][2], st[qt][2 * k2 + 1][3]); pf[qt][k2] = __builtin_bit_cast(bf16x8, w); }
            }
            __builtin_amdgcn_sched_barrier(0);
            const unsigned vtb = (unsigned)(__SIZE_TYPE__)(lds + AT_VT) + (unsigned)((4 * fq + (fr >> 2)) * 288 + (fr & 3) * 8);
#define AT_TR(dst, OFF) asm volatile("ds_read_b64_tr_b16 %0, %1 offset:%2" : "=&v"(dst) : "v"(vtb), "i"(OFF) : "memory")
#pragma unroll
            for (int dp = 0; dp < 4; ++dp) {
                u32x2 lo[2][2], hi[2][2];
#pragma unroll
                for (int dd = 0; dd < 2; ++dd)
#pragma unroll
                    for (int k2 = 0; k2 < 2; ++k2) { AT_TR(lo[dd][k2], (2 * dp + dd) * 32 + k2 * 32 * 288); AT_TR(hi[dd][k2], (2 * dp + dd) * 32 + k2 * 32 * 288 + 16 * 288); }
                asm volatile("s_waitcnt lgkmcnt(0)" ::: "memory"); __builtin_amdgcn_sched_barrier(0);
#pragma unroll
                for (int dd = 0; dd < 2; ++dd)
#pragma unroll
                    for (int k2 = 0; k2 < 2; ++k2) { const int dt = 2 * dp + dd;
                        u32x4 w; w.x = lo[dd][k2].x; w.y = lo[dd][k2].y; w.z = hi[dd][k2].x; w.w = hi[dd][k2].y; const bf16x8 vf = __builtin_bit_cast(bf16x8, w);
                        O[dt][0] = __builtin_amdgcn_mfma_f32_16x16x32_bf16(vf, pf[0][k2], O[dt][0], 0, 0, 0); O[dt][1] = __builtin_amdgcn_mfma_f32_16x16x32_bf16(vf, pf[1][k2], O[dt][1], 0, 0, 0); }
                __builtin_amdgcn_sched_barrier(0);
            }
#undef AT_TR
        }
    }
#undef AT_LOAD
#pragma unroll
    for (int qt = 0; qt < 2; ++qt) { const float inv = 1.0f / l_run[qt]; const int row = R0 + 32 * wid + 16 * qt + fr; bf16_t* yr = Y + (size_t)row * 2048 + h * 128 + 4 * fq; float sq = 0.f;
#pragma unroll
        for (int dt = 0; dt < 8; ++dt) { const f32x4 o = O[dt][qt] * inv; sq += (o[0] * o[0] + o[1] * o[1]) + (o[2] * o[2] + o[3] * o[3]); u32x2 w; w.x = cvt_pk_bf16(o[0], o[1]); w.y = cvt_pk_bf16(o[2], o[3]); *(u32x2*)(yr + 16 * dt) = w; }
        sq += shx(sq, 16); sq += shx(sq, 32); ys[(size_t)row * 16 + h] = sq; }
}

constexpr int GM_RS = 528;
__device__ __forceinline__ void gmlp2_unit(LAS unsigned char* lds, const bf16_t* Z, bf16_t* Y, float* ys, const bf16_t* Wsm_l, const float* bs_l, const float* vs, const float* lng, const float* lnb, int nb, int gp, int tid, int wid, int lane) {
    const int fr = lane & 15, fq = lane >> 4;
    __syncthreads();
    {   const int t = tid & 127;
        const f32x4* sp = (const f32x4*)(vs + (size_t)(nb * 128 + t) * 32);
        float s1 = 0.f, s2 = 0.f;
#pragma unroll
        for (int i = 0; i < 8; ++i) { const f32x4 q = sp[i]; s1 += q[0] + q[2]; s2 += q[1] + q[3]; }
        const float mu = s1 * (1.0f / 1024.0f), rstd = 1.0f / sqrtf(fmaxf(s2 * (1.0f / 1024.0f) - mu * mu, 0.f) + EPS_);
        const bf16_t* zr = Z + (size_t)(nb * 128 + t) * NIN_ + 4096 + gp * 256;
        u32x4 v[8];
#pragma unroll
        for (int i = 0; i < 8; ++i) v[i] = *(const u32x4*)(zr + ((tid >> 7) + 4 * i) * 8);
#pragma unroll
        for (int i = 0; i < 8; ++i) { const int dch = (tid >> 7) + 4 * i;
            const float* gpn = lng + gp * 256 + dch * 8; const float* bpn = lnb + gp * 256 + dch * 8;
            const f32x4 g0 = *(const f32x4*)gpn, g1 = *(const f32x4*)(gpn + 4), b0 = *(const f32x4*)bpn, b1 = *(const f32x4*)(bpn + 4);
            u32x4 w;
            w.x = cvt_pk_bf16((bf_lo(v[i].x) - mu) * rstd * g0[0] + b0[0], (bf_hi(v[i].x) - mu) * rstd * g0[1] + b0[1]); w.y = cvt_pk_bf16((bf_lo(v[i].y) - mu) * rstd * g0[2] + b0[2], (bf_hi(v[i].y) - mu) * rstd * g0[3] + b0[3]);
            w.z = cvt_pk_bf16((bf_lo(v[i].z) - mu) * rstd * g1[0] + b1[0], (bf_hi(v[i].z) - mu) * rstd * g1[1] + b1[1]); w.w = cvt_pk_bf16((bf_lo(v[i].w) - mu) * rstd * g1[2] + b1[2], (bf_hi(v[i].w) - mu) * rstd * g1[3] + b1[3]);
            *(LAS u32x4*)(lds + t * GM_RS + dch * 16) = w; } }
    const int row = nb * 128 + 16 * wid + fr;
    const unsigned gtb = (unsigned)(__SIZE_TYPE__)lds + (unsigned)((8 * fq + (fr >> 2)) * GM_RS + (fr & 3) * 8);
    __syncthreads();
#pragma unroll
    for (int g2 = 0; g2 < 2; ++g2) {
        const int g = 2 * gp + g2;
        bf16x8 wsf[4];
#pragma unroll
        for (int ks = 0; ks < 4; ++ks) wsf[ks] = *(const bf16x8*)(Wsm_l + (size_t)(g * 128 + 16 * wid + fr) * 128 + 32 * ks + 8 * fq);
        const float bs = bs_l[g * 128 + 16 * wid + fr]; float ysq = 0.f;
        u32x2 uu[8];
#pragma unroll
        for (int ct = 0; ct < 8; ++ct) uu[ct] = *(const u32x2*)(Z + (size_t)row * NIN_ + 3072 + g * 128 + 16 * ct + 4 * fq);
#pragma unroll
        for (int ct = 0; ct < 8; ++ct) {
            f32x4 acc = (f32x4){0.f, 0.f, 0.f, 0.f};
            {   u32x2 lo[4], hi[4];
#pragma unroll
                for (int ks = 0; ks < 4; ++ks) {
                    asm volatile("ds_read_b64_tr_b16 %0, %1 offset:%2" : "=&v"(lo[ks]) : "v"(gtb), "i"(ks * 32 * GM_RS + g2 * 256 + ct * 32) : "memory");
                    asm volatile("ds_read_b64_tr_b16 %0, %1 offset:%2" : "=&v"(hi[ks]) : "v"(gtb), "i"(ks * 32 * GM_RS + 4 * GM_RS + g2 * 256 + ct * 32) : "memory"); }
                asm volatile("s_waitcnt lgkmcnt(0)" ::: "memory"); __builtin_amdgcn_sched_barrier(0);
#pragma unroll
                for (int ks = 0; ks < 4; ++ks) { u32x4 w; w.x = lo[ks].x; w.y = lo[ks].y; w.z = hi[ks].x; w.w = hi[ks].y; acc = __builtin_amdgcn_mfma_f32_16x16x32_bf16(__builtin_bit_cast(bf16x8, w), wsf[ks], acc, 0, 0, 0); }
            }
            const float y0 = bf_lo(uu[ct].x) * (acc[0] + bs), y1 = bf_hi(uu[ct].x) * (acc[1] + bs), y2 = bf_lo(uu[ct].y) * (acc[2] + bs), y3 = bf_hi(uu[ct].y) * (acc[3] + bs);
            ysq += (y0 * y0 + y1 * y1) + (y2 * y2 + y3 * y3);
            u32x2 w; w.x = cvt_pk_bf16(y0, y1); w.y = cvt_pk_bf16(y2, y3);
            *(u32x2*)(Y + (size_t)row * 2048 + 1024 + g * 128 + 16 * ct + 4 * fq) = w;
        }
        ysq += shx(ysq, 16); ysq += shx(ysq, 32); ys[(size_t)row * 16 + 8 + g] = ysq;
    }
}

#define PROBE_DUP 0
#define NREP(k) ((PROBE_DUP == (k)) ? 2 : 1)
__global__ void __launch_bounds__(NWAVES * 64, 2) mega_fwd(Args a) {
    extern __shared__ __attribute__((aligned(16))) unsigned char lds_raw[];
    LAS unsigned char* lds = (LAS unsigned char*)lds_raw;
    cg::grid_group grid = cg::this_grid();
    int tid = threadIdx.x, lane = tid & 63, wid = __builtin_amdgcn_readfirstlane(tid >> 6);
    const int G = (int)gridDim.x, NGW = G * NWAVES; int gw = (int)blockIdx.x * NWAVES + wid;
#define PHASE_BEGIN() do { tid = threadIdx.x; asm volatile("" : "+v"(tid)); lane = tid & 63; wid = __builtin_amdgcn_readfirstlane(tid >> 6); gw = (int)blockIdx.x * NWAVES + wid; } while (0)
    unsigned char* const ws = a.ws;
#define XN ((bf16_t*)(ws + WS_XN))
#define HB ((bf16_t*)(ws + WS_H))
#define ZB ((bf16_t*)(ws + WS_H))
#define YB ((bf16_t*)(ws + WS_Y))
#define QM ((bf16_t*)(ws + WS_Y))
#define SC ((float*)(ws + WS_H))
#define PB ((bf16_t*)(ws + WS_H + H_OFF_P))
#define WKV ((bf16_t*)(ws + WS_WKV))
#define WSM ((bf16_t*)(ws + WS_WSM))
#define AMEM ((bf16_t*)(ws + WS_AMEM))
#define KVALL ((bf16_t*)(ws + WS_KVALL))
#define KN ((bf16_t*)(ws + WS_KN))
#define X (a.out)
#define SS ((float*)(ws + WS_SS))
#define QS ((float*)(ws + WS_QS))
#define VS ((float*)(ws + WS_VS))
#define YS ((float*)(ws + WS_YS))
#define YS ((float*)(ws + WS_YS))

    volatile LAS unsigned* bst = (volatile LAS unsigned*)(lds + 131072 + 12288);
    if (tid == 0) { bst[0] = 0u; bst[1] = 0u; }

    constexpr int I_1 = (D_ / 64) * (2 * FF_ / 32), I_2 = (FF_ / 64) * (D_ / 32), I_IN = (D_ / 64) * (NIN_ / 32), I_DD = (D_ / 64) * (D_ / 32), I_KV = (D_ / 64) * (2 * D_ / 32);
    constexpr int PER_L = 2 * I_1 + 2 * I_2 + I_IN + 3 * I_DD + I_KV;
#define T_DECODE(d, it_) do { const int l = (it_) / PER_L; int r = (it_) % PER_L; unsigned char* wl = ws + (size_t)l * LO_END; \
            if (r < I_1) { t_desc<1>(d, a.in[I_W_FFN1_IN] + (size_t)l * D_ * 2 * FF_, D_, 2 * FF_, (bf16_t*)(wl + LO_W1A), a.in[I_G_FFN1] + l * D_, r); break; } r -= I_1; \
            if (r < I_1) { t_desc<1>(d, a.in[I_W_FFN2_IN] + (size_t)l * D_ * 2 * FF_, D_, 2 * FF_, (bf16_t*)(wl + LO_W1B), a.in[I_G_FFN2] + l * D_, r); break; } r -= I_1; \
            if (r < I_2) { t_desc<0>(d, a.in[I_W_FFN1_OUT] + (size_t)l * FF_ * D_, FF_, D_, (bf16_t*)(wl + LO_W2A), nullptr, r); break; } r -= I_2; \
            if (r < I_2) { t_desc<0>(d, a.in[I_W_FFN2_OUT] + (size_t)l * FF_ * D_, FF_, D_, (bf16_t*)(wl + LO_W2B), nullptr, r); break; } r -= I_2; \
            if (r < I_IN) { t_desc<0>(d, a.in[I_W_IN] + (size_t)l * D_ * NIN_, D_, NIN_, (bf16_t*)(wl + LO_WIN), a.in[I_G_MIX] + l * D_, r); break; } r -= I_IN; \
            if (r < I_DD) { const int kb_ = r / (D_ / 32); t_desc<0>(d, a.in[I_W_OUT] + (size_t)l * D_ * D_, D_, D_, (bf16_t*)(wl + LO_WOUT), (kb_ < 16 ? a.in[I_G_OUT_A] + l * 1024 : a.in[I_G_OUT_B] + l * 1024 - 1024), r); break; } r -= I_DD; \
            if (r < I_DD) { t_desc<0>(d, a.in[I_W_MEM_Q] + (size_t)l * D_ * D_, D_, D_, (bf16_t*)(wl + LO_WQ), a.in[I_G_MEM_Q] + l * D_, r); break; } r -= I_DD; \
            if (r < I_DD) { t_desc<0>(d, a.in[I_W_MEM_O] + (size_t)l * D_ * D_, D_, D_, (bf16_t*)(wl + LO_WO), nullptr, r); break; } r -= I_DD; \
            t_desc<0>(d, a.in[I_W_MEM_KV] + (size_t)l * D_ * 2 * D_, D_, 2 * D_, WKV + (size_t)l * 2 * D_ * D_, nullptr, r); } while (0)
#define CONVERT(first_, stride_, count_, MAPJ) do { TDesc dc, dn; f32x4 va[8], vb[8], ga[2], gb[2]; int j_ = (first_); \
        if (j_ < (count_)) { const int it_ = MAPJ(j_); T_DECODE(dc, it_); t_load(dc, lane, va, ga); } \
        for (; j_ < (count_); j_ += (stride_)) { const bool more_ = j_ + (stride_) < (count_); \
            if (more_) { const int it_ = MAPJ(j_ + (stride_)); T_DECODE(dn, it_); t_load(dn, lane, vb, gb); } \
            t_store(dc, lane, va, ga, scr); \
            if (more_) { dc = dn; _Pragma("unroll") for (int q_ = 0; q_ < 8; ++q_) va[q_] = vb[q_]; ga[0] = gb[0]; ga[1] = gb[1]; } } } while (0)
#define MAP_ALL(j) (j)
#define MAP_SET0(j) ((j) < I_1 ? (j) : (((j) - I_1) / I_KV) * PER_L + (PER_L - I_KV) + ((j) - I_1) % I_KV)
#define MAP_SET1(j) ((j) < (PER_L - I_KV - I_1) ? I_1 + (j) : PER_L + ((j) - (PER_L - I_KV - I_1)))
    constexpr int N_SET0 = I_1 + 2 * I_KV, N_SET1 = 2 * PER_L - N_SET0;
    const int ng1 = (G == 256) ? 216 : G;
    {
        LAS float* scr = (LAS float*)(lds + wid * 16384);
        { const bool sp0 = ng1 < G; const int cnt0 = sp0 ? N_SET0 : 2 * PER_L;
#define MAP_P0(j) (sp0 ? MAP_SET0(j) : (j))
          CONVERT(gw, NGW, cnt0, MAP_P0); }
        for (int i = (int)blockIdx.x * 512 + tid; i < 2 * 8 * 128 * 128 / 2; i += G * 512) {
            const int e = 2 * i, t = e & 127, s = (e >> 7) & 127; const f32x2 w = *(const f32x2*)(a.in[I_W_S] + e);
            const bool keep = (s >> 6) >= (t >> 6);
            ((unsigned*)WSM)[i] = keep ? cvt_pk_bf16(w.x, w.y) : 0u;
        }
        if (gw < 2) for (int d = lane; d < 128; d += 64) ((float*)(ws + WS_GQK))[gw * 128 + d] = a.in[I_G_Q_A][gw * 128 + d] * a.in[I_G_K_A][gw * 128 + d] * 0.08838834764831845f;
        for (int l = 0; l < 2; ++l) rms_rows_2048(a.in[I_MEM], a.in[I_G_MEM_KV] + l * D_, AMEM + (size_t)l * 256 * D_, 256, gw, NGW, lane);
        rows_bf16_ss(a.in[I_X], XN, SS, S_, gw, NGW, lane);
    }
    if (a.ws == nullptr) grid.sync();
    const XcdBarrier xbar = xcd_barrier_post((unsigned*)(ws + WS_BAR), bst);
#define GRID_BAR() xcd_barrier(xbar)
    GRID_BAR(); PHASE_BEGIN();
    if (PROBE_DUP == 6) { for (int i = 0; i < 10; ++i) GRID_BAR(); }

    if (ng1 < G && (int)blockIdx.x >= ng1) {
        LAS float* scr = (LAS float*)(lds + wid * 16384);
        CONVERT(((int)blockIdx.x - ng1) * NWAVES + wid, (G - ng1) * NWAVES, N_SET1, MAP_SET1);
        PHASE_BEGIN();
    }
#pragma unroll
    for (int l = 0; l < 2; ++l) {
        unsigned char* wl = ws + (size_t)l * LO_END;
        const float* xin = (l == 0) ? a.in[I_X] : X;
        const bool split = (l == 0) && (ng1 < G);
        if (!split || (int)blockIdx.x < ng1) {
            pg8::Gemm g{XN, (const bf16_t*)(wl + LO_W1A), D_, D_, D_, S_ / 256, 2 * FF_ / 256, 256u * D_ * 2u, 0, 0, 256u * D_ * 2u, 0, split ? ng1 : 0};
            pg8::Epi<1, true> E{HB, FF_, nullptr, 1.f, 0, SS, nullptr, nullptr, nullptr, 0, 0, nullptr}; pg8::gemm_phase(lds, g, E); }
        if (l == 0) {
            if (!split || (int)blockIdx.x < ng1) {
                for (int ll = 0; ll < 2; ++ll) {
                    pg8::Gemm g{AMEM + (size_t)ll * 256 * D_, WKV + (size_t)ll * 2 * D_ * D_, D_, D_, D_, 1, 16, 0, 0, 0, 256u * D_ * 2u, split ? (ll ? 40 : 56) : 0, split ? ng1 : 0};
                    pg8::Epi<0> E{KVALL + (size_t)ll * 256 * 8192 + ll * 4096, 8192, nullptr, 1.f, 1 << 30, nullptr, nullptr, nullptr, nullptr, 0, 0, nullptr}; pg8::gemm_phase(lds, g, E); }
            }
        }
        GRID_BAR(); PHASE_BEGIN();
        {   pg8::Gemm g{HB, (const bf16_t*)(wl + LO_W2A), FF_, FF_, FF_, S_ / 256, D_ / 256, 256u * FF_ * 2u, 0, 0, 256u * FF_ * 2u, 0};
            if (PROBE_DUP == 3 && l == 1) { pg8::Epi<2, true> E2{(float*)(ws + WS_END), D_, xin, 0.5f, 0, nullptr, YB, (float*)(ws + WS_END + (size_t)S_ * D_ * 4), nullptr, 0, 0, nullptr}; pg8::gemm_phase(lds, g, E2); }
            pg8::Epi<2, true> E{X, D_, xin, 0.5f, 0, nullptr, XN, SS, nullptr, 0, 0, nullptr}; pg8::gemm_phase(lds, g, E); }
        if (l == 0) {
            PHASE_BEGIN();
            for (int ll = 0; ll < 2; ++ll) headnorm512_rows(KVALL + (size_t)ll * 256 * 8192 + ll * 4096, 8192, KN + (size_t)ll * 256 * D_, D_, a.in[I_G_K_MEM] + ll * 512, a.in[I_G_Q_MEM] + ll * 512, 0.04419417382415922f, 256, gw, NGW, lane);
            for (int ll = 0; ll < 2; ++ll) {
                pg8::Gemm g{(const bf16_t*)(ws + (size_t)ll * LO_END + LO_WO), KVALL + (size_t)ll * 256 * 8192 + ll * 4096 + 2048, D_, 8192, 512, 8, 4, 256u * D_ * 2u, 512u * 2u, 0, 512u * 2u,ll ? 224 : 0};
                pg8::Epi<0> E{(bf16_t*)(ws + (size_t)ll * LO_END + LO_VW), 1024, nullptr, 1.f, 1 << 30, nullptr, nullptr, nullptr, nullptr, 0, 0, nullptr}; pg8::gemm_phase(lds, g, E); }
        }
        GRID_BAR(); PHASE_BEGIN();
        {   pg8::Gemm g{XN, (const bf16_t*)(wl + LO_WIN), D_, D_, D_, S_ / 256, NIN_ / 256, 256u * D_ * 2u, 0, 0, 256u * D_ * 2u, 0};
            pg8::Epi<0, true, true, true> E{ZB, NIN_, (const float*)(ws + WS_GQK) + l * 128, 1.f, 12, SS, nullptr, nullptr, VS, 16, 16, lds + 131072}; for (int rep = 0; rep < (l == 1 ? NREP(4) : 1); ++rep) pg8::gemm_phase(lds, g, E); }
        GRID_BAR(); PHASE_BEGIN();
#ifndef NO_ATTN
        for (int rep = 0; rep < (l == 1 ? NREP(5) : 1); ++rep)
        for (int it = (int)blockIdx.x; it < 512 + 512; it += G) {
            if (it < 512) attn_unit(lds, ZB, YB, YS, a.in[I_REL] + (size_t)l * 8 * 513, a.in[I_G_Q_A] + l * 128, a.in[I_G_K_A] + l * 128, it & 7, it >> 3, tid, wid, lane);
            else { const int j = it - 512; gmlp2_unit(lds, ZB, YB, YS, WSM + (size_t)l * 8 * 128 * 128, a.in[I_B_S] + l * 1024, VS, a.in[I_LN_G] + l * 1024, a.in[I_LN_B] + l * 1024, j >> 2, j & 3, tid, wid, lane); }
        }
#endif
        GRID_BAR(); PHASE_BEGIN();
        {   pg8::Gemm g{YB, (const bf16_t*)(wl + LO_WOUT), D_, D_, D_, S_ / 256, D_ / 256, 256u * D_ * 2u, 0, 0, 256u * D_ * 2u, 0};
            pg8::Epi<5> E{X, D_, X, 1.0f, 0, YS, XN, SS, nullptr, 0, 0, nullptr}; pg8::gemm_phase(lds, g, E); }
        GRID_BAR(); PHASE_BEGIN();
        {   pg8::Gemm g{XN, (const bf16_t*)(wl + LO_WQ), D_, D_, D_, S_ / 256, D_ / 256, 256u * D_ * 2u, 0, 0, 256u * D_ * 2u, 0};
            pg8::Epi<0, true, true> E{QM, D_, nullptr, 1.f, 1 << 30, SS, nullptr, nullptr, QS, 32, 0, nullptr}; pg8::gemm_phase(lds, g, E); }
        GRID_BAR(); PHASE_BEGIN();
        {   pg8::Gemm g{QM, KN + (size_t)l * 256 * D_, D_, D_, 512, S_ / 256, 4, 256u * D_ * 2u, 512u * 2u, 0, 512u * 2u, 0};
            pg8::Epi<4> E{PB, 1024, nullptr, 1.f, 0, QS, nullptr, nullptr, nullptr, 0, 0, lds + 131072}; pg8::gemm_phase(lds, g, E); }
        GRID_BAR(); PHASE_BEGIN();
        {   pg8::Gemm g{PB, (const bf16_t*)(wl + LO_VW), 1024, 1024, 1024, S_ / 256, D_ / 256, 256u * 1024u * 2u, 0, 0, 256u * 1024u * 2u, 0};
            pg8::Epi<2, true> E{X, D_, X, 1.0f, 0, nullptr, XN, SS, nullptr, 0, 0, nullptr}; pg8::gemm_phase(lds, g, E); }
        GRID_BAR(); PHASE_BEGIN();
        {   pg8::Gemm g{XN, (const bf16_t*)(wl + LO_W1B), D_, D_, D_, S_ / 256, 2 * FF_ / 256, 256u * D_ * 2u, 0, 0, 256u * D_ * 2u, 0};
            pg8::Epi<1, true> E{HB, FF_, nullptr, 1.f, 0, SS, nullptr, nullptr, nullptr, 0, 0, nullptr}; pg8::gemm_phase(lds, g, E); }
        GRID_BAR(); PHASE_BEGIN();
        {   pg8::Gemm g{HB, (const bf16_t*)(wl + LO_W2B), FF_, FF_, FF_, S_ / 256, D_ / 256, 256u * FF_ * 2u, 0, 0, 256u * FF_ * 2u, 0};
            if (l == 0) { pg8::Epi<2, true> E{X, D_, X, 0.5f, 0, nullptr, XN, SS, nullptr, 0, 0, nullptr}; pg8::gemm_phase(lds, g, E); }
            else { pg8::Epi<2, false> E{X, D_, X, 0.5f, 0, nullptr, nullptr, nullptr, nullptr, 0, 0, nullptr}; pg8::gemm_phase(lds, g, E); } }
        if (l == 0) { GRID_BAR(); PHASE_BEGIN(); }
    }
}

extern "C" void kernel_launch(void* const* d_in, const int* in_sizes, int n_in, void* d_out, int out_size, void* d_ws, size_t ws_size, hipStream_t stream) {
    static int grid = 0;
    if (grid == 0) {
        if (n_in != 27 || out_size != S_ * D_ || ws_size < WS_END + (size_t)S_ * D_ * 4 + (size_t)S_ * 128) { fprintf(stderr, "kernel_launch: unexpected shapes (n_in %d out %d ws %zu need %zu)\n", n_in, out_size, ws_size, (size_t)WS_END); grid = -1; return; }
        int dev = 0, cus = 0, per_cu = 0;
        hipGetDevice(&dev);
        hipDeviceGetAttribute(&cus, hipDeviceAttributeMultiprocessorCount, dev);
        if (hipFuncSetAttribute((const void*)mega_fwd, hipFuncAttributeMaxDynamicSharedMemorySize, LDS_BYTES) != hipSuccess) { fprintf(stderr, "kernel_launch: hipFuncSetAttribute failed\n"); grid = -1; return; }
        if (hipOccupancyMaxActiveBlocksPerMultiprocessor(&per_cu, (const void*)mega_fwd, NWAVES * 64, LDS_BYTES) != hipSuccess || per_cu < 1) { fprintf(stderr, "kernel_launch: occupancy query gave %d\n", per_cu); per_cu = 1; }
        (void)hipGetLastError();
        grid = cus * per_cu;
    }
    if (grid < 0) return;
    Args a{};
    for (int i = 0; i < 27; ++i) a.in[i] = (const float*)d_in[i];
    a.out = (float*)d_out; a.ws = (unsigned char*)d_ws;
    void* args[] = {&a};
    if (hipMemsetAsync((unsigned char*)d_ws + WS_BAR, 0, 16384, stream) != hipSuccess) { fprintf(stderr, "kernel_launch: hipMemsetAsync of the barrier words failed\n"); return; }
    hipError_t e = hipLaunchCooperativeKernel((const void*)mega_fwd, dim3(grid), dim3(NWAVES * 64), args, LDS_BYTES, stream);
    if (e != hipSuccess) fprintf(stderr, "kernel_launch: cooperative launch failed: %s (grid %d)\n", hipGetErrorString(e), grid);
}
```
